# Optimizing an MI355X kernel written in HIP

```python
import math
import jax, jax.numpy as jnp
from jax import lax
import numpy as np

D_MODEL = 4096
BATCH = 2
SEQ = 4096
DEPTH = 2

GRID_W = 64
CTX_LEN = 256
EPS = 1e-6

SSM_GROUPS = 64
SSM_GROUP_CH = 16
SSM_STATE = 64
SSM_WIDTH = SSM_GROUPS * SSM_GROUP_CH
DT_MIN = 1e-3
DT_MAX = 1e-1
GLA_HEADS = 8
GLA_DK = 64
GLA_DV = 128
GLA_KW = GLA_HEADS * GLA_DK
GLA_VW = GLA_HEADS * GLA_DV
GLA_RANK = 16
GLA_TAU = 16.0
GLA_CHUNK = 16
ATTN_HEADS = 16
ATTN_KV_HEADS = 4
HEAD_DIM = 128
ATTN_QW = ATTN_HEADS * HEAD_DIM
ATTN_KVW = ATTN_KV_HEADS * HEAD_DIM
Q_BLOCK = 128
ROPE_THETA = 10000.0
N_BRANCH = 3

IN_SPLITS = (SSM_WIDTH, SSM_WIDTH,
             GLA_KW, GLA_KW, GLA_VW, GLA_VW, 2 * GLA_RANK,
             ATTN_QW, ATTN_KVW, ATTN_KVW, ATTN_QW,
             N_BRANCH * D_MODEL)
IN_WIDTH = 22560

kernel_name = "hybrid_s5_gla_gqa_prefix_dit"


def rms_norm(x, g):
    xf = x.astype(jnp.float32)
    y = xf * lax.rsqrt(jnp.mean(xf * xf, axis=-1, keepdims=True) + EPS)
    return (y * g.astype(jnp.float32)).astype(x.dtype)


def split_columns(p):
    offsets = np.cumsum(IN_SPLITS)[:-1].tolist()
    return jnp.split(p, offsets, axis=-1)


def s5_discretize(lam_re, lam_im, log_dt, b_re, b_im):
    f32 = jnp.float32
    lam = lax.complex(jnp.minimum(lam_re.astype(f32), -1e-4), lam_im.astype(f32))
    dt = jnp.exp(log_dt.astype(f32))[:, None]
    lam_bar = jnp.exp(lam * dt)
    b = lax.complex(b_re.astype(f32), b_im.astype(f32))
    b_bar = ((lam_bar - 1.0) / lam)[..., None] * b
    return lam_bar, b_bar


def s5_scan(lam_bar, bu, h0, reverse):
    if h0 is not None:
        edge = bu.shape[0] - 1 if reverse else 0
        bu = bu.at[edge].add(lam_bar * h0)
    a = jnp.broadcast_to(lam_bar, (bu.shape[0], 1) + lam_bar.shape)

    def combine(e1, e2):
        a1, b1 = e1
        a2, b2 = e2
        return a1 * a2, a2 * b1 + b2

    _, h = lax.associative_scan(combine, (a, bu), reverse=reverse)
    return h


def s5_branch(u_lat, u_ctx, lam_re, lam_im, log_dt, b_re, b_im, c_re, c_im, d_skip, ctx_out):
    f32 = jnp.float32
    B, T, _ = u_lat.shape
    Bc, Tc, _ = u_ctx.shape
    ul = u_lat.astype(f32).reshape(B, T, SSM_GROUPS, SSM_GROUP_CH)
    uc = u_ctx.astype(f32).reshape(Bc, Tc, SSM_GROUPS, SSM_GROUP_CH)
    d = d_skip.astype(f32).reshape(SSM_GROUPS, SSM_GROUP_CH)
    y_lat = d * ul
    y_ctx = d * uc if ctx_out else None
    for direction in range(2):
        reverse = direction == 1
        lam_bar, b_bar = s5_discretize(lam_re[direction], lam_im[direction], log_dt[direction],
                                       b_re[direction], b_im[direction])
        c_mat = lax.complex(c_re[direction].astype(f32), c_im[direction].astype(f32))
        h_ctx = s5_scan(lam_bar, jnp.einsum('btgp,gnp->tbgn', uc, b_bar), None, reverse)
        h0 = h_ctx[0] if reverse else h_ctx[-1]
        h_lat = s5_scan(lam_bar, jnp.einsum('btgp,gnp->tbgn', ul, b_bar), h0, reverse)
        y_lat = y_lat + jnp.einsum('tbgn,gpn->btgp', h_lat, c_mat).real
        if ctx_out:
            y_ctx = y_ctx + jnp.einsum('tbgn,gpn->btgp', h_ctx, c_mat).real
    y_lat = y_lat.reshape(B, T, SSM_WIDTH)
    if ctx_out:
        y_ctx = y_ctx.reshape(Bc, Tc, SSM_WIDTH)
    return y_lat, y_ctx


def gla_chunked(q, k, v, log_a, s0, need_out):
    B, T, H, DK = q.shape
    DV = v.shape[-1]
    C = GLA_CHUNK
    n = T // C
    q, k, log_a = (t.reshape(B, n, C, H, DK) for t in (q, k, log_a))
    v = v.reshape(B, n, C, H, DV)
    b = jnp.cumsum(log_a, axis=2)
    b_end = b[:, :, -1]
    kv_chunk = jnp.einsum('bnchk,bnchv->bnhkv', k * jnp.exp(b_end[:, :, None] - b), v)
    if s0 is None:
        s0 = jnp.zeros((B, H, DK, DV), jnp.float32)

    def step(s, inp):
        dec, kv = inp
        return dec[..., None] * s + kv, s

    s_final, s_start = lax.scan(step, s0, (jnp.moveaxis(jnp.exp(b_end), 1, 0), jnp.moveaxis(kv_chunk, 1, 0)))
    if not need_out:
        return None, s_final
    s_start = jnp.moveaxis(s_start, 0, 1)
    o_inter = jnp.einsum('bnchk,bnhkv->bnchv', q * jnp.exp(b), s_start)
    causal = jnp.tril(jnp.ones((C, C), dtype=bool))
    rel = jnp.where(causal[:, :, None, None], b[:, :, :, None] - b[:, :, None, :], -jnp.inf)
    scores = jnp.einsum('bnthk,bnshk,bntshk->bnths', q, k, jnp.exp(rel))
    o_intra = jnp.einsum('bnths,bnshv->bnthv', scores, v)
    return (o_inter + o_intra).reshape(B, T, H, DV), s_final


def gla_branch(q_l, k_l, v_l, lr_l, q_c, k_c, v_c, lr_c, w_a, b_a, g_o, ctx_out):
    f32 = jnp.float32

    def heads(t, d):
        return t.astype(f32).reshape(t.shape[0], t.shape[1], GLA_HEADS, d)

    def log_gate(lr, direction):
        z = (lr[..., direction * GLA_RANK:(direction + 1) * GLA_RANK].astype(f32) @ w_a[direction].astype(f32)
             + b_a[direction].astype(f32))
        return heads(jax.nn.log_sigmoid(z) / GLA_TAU, GLA_DK)

    scale = GLA_DK ** -0.5
    lat = [heads(q_l, GLA_DK) * scale, heads(k_l, GLA_DK), heads(v_l, GLA_DV)]
    con = [heads(q_c, GLA_DK) * scale, heads(k_c, GLA_DK), heads(v_c, GLA_DV)]
    y_l, y_c = 0.0, 0.0
    for direction in range(2):
        if direction == 1:
            orient = lambda t: jnp.flip(t, axis=1)
        else:
            orient = lambda t: t
        qc, kc, vc = [orient(t) for t in con]
        ql, kl, vl = [orient(t) for t in lat]
        o_c, s_c = gla_chunked(qc, kc, vc, orient(log_gate(lr_c, direction)), None, ctx_out)
        o_l, _ = gla_chunked(ql, kl, vl, orient(log_gate(lr_l, direction)), s_c, True)
        y_l = y_l + orient(o_l)
        if ctx_out:
            y_c = y_c + orient(o_c)
    y_l = rms_norm(y_l, g_o).reshape(q_l.shape[0], q_l.shape[1], GLA_VW)
    y_c = rms_norm(y_c, g_o).reshape(q_c.shape[0], q_c.shape[1], GLA_VW) if ctx_out else None
    return y_l, y_c


def axial_rotary(rows):
    f32 = jnp.float32
    n_freq = HEAD_DIM // 4
    row = jnp.repeat(jnp.arange(rows, dtype=f32), GRID_W)
    col = jnp.tile(jnp.arange(GRID_W, dtype=f32), rows)
    inv_freq = ROPE_THETA ** (-jnp.arange(n_freq, dtype=f32) / n_freq)
    ang = jnp.stack([row[:, None] * inv_freq, col[:, None] * inv_freq], axis=1)
    ang = jnp.concatenate([ang, ang], axis=-1).reshape(rows * GRID_W, HEAD_DIM)
    return jnp.cos(ang)[:, None, :], jnp.sin(ang)[:, None, :]


def apply_axial_rotary(x, cos, sin):
    xr = x.reshape(x.shape[:-1] + (2, 2, HEAD_DIM // 4))
    rot = jnp.concatenate([-xr[..., 1:, :], xr[..., :1, :]], axis=-2).reshape(x.shape)
    return x * cos + rot * sin


def attention_branch(q_l, k_l, v_l, q_c, k_c, v_c, g_q, g_k, cos, sin, ctx_out):
    f32 = jnp.float32
    B, T, _ = q_l.shape
    Bc, Tc, _ = k_c.shape
    n_rep = ATTN_HEADS // ATTN_KV_HEADS
    scale = HEAD_DIM ** -0.5
    ql = apply_axial_rotary(rms_norm(q_l.reshape(B, T, ATTN_HEADS, HEAD_DIM), g_q), cos, sin)
    kl = apply_axial_rotary(rms_norm(k_l.reshape(B, T, ATTN_KV_HEADS, HEAD_DIM), g_k), cos, sin)
    vl = v_l.reshape(B, T, ATTN_KV_HEADS, HEAD_DIM)
    kc = rms_norm(k_c.reshape(Bc, Tc, ATTN_KV_HEADS, HEAD_DIM), g_k)
    vc = v_c.reshape(Bc, Tc, ATTN_KV_HEADS, HEAD_DIM)
    keys = jnp.concatenate([kc, kl], axis=1).astype(f32)
    vals = jnp.concatenate([vc, vl], axis=1).astype(f32)

    def attend(qb, kk, vv):
        s = jnp.einsum('bqkgd,bskd->bkgqs', qb.astype(f32), kk) * scale
        p = jax.nn.softmax(s, axis=-1)
        return jnp.einsum('bkgqs,bskd->bqkgd', p, vv)

    nb = T // Q_BLOCK
    qb = ql.reshape(B, nb, Q_BLOCK, ATTN_KV_HEADS, n_rep, HEAD_DIM).swapaxes(0, 1)
    o = lax.map(lambda blk: attend(blk, keys, vals), qb)
    y_l = o.swapaxes(0, 1).reshape(B, T, ATTN_QW)
    y_c = None
    if ctx_out:
        qc = rms_norm(q_c.reshape(Bc, Tc, ATTN_KV_HEADS, n_rep, HEAD_DIM), g_q)
        y_c = attend(qc, kc.astype(f32), vc.astype(f32)).reshape(Bc, Tc, ATTN_QW)
    return y_l, y_c


def merge_branches(y_ssm, z_ssm, y_gla, z_gla, y_attn, z_attn, gate_logits, w_glu, w_ps, w_pg, w_pa, w_o):
    g = jax.nn.gelu(y_ssm)
    s = g * jax.nn.sigmoid(g @ w_glu) * jax.nn.silu(z_ssm)
    gl = y_gla * jax.nn.silu(z_gla)
    at = y_attn * jax.nn.silu(z_attn)
    gates = jax.nn.sigmoid(gate_logits.astype(jnp.float32))
    g_s, g_g, g_a = jnp.split(gates, N_BRANCH, axis=-1)
    merged = g_s * (s @ w_ps) + g_g * (gl @ w_pg) + g_a * (at @ w_pa)
    return merged @ w_o


def setup_inputs(seed: int = 0) -> dict:
    key = jax.random.key(seed)
    keys = iter(jax.random.split(key, 40))

    def normal(shape, std):
        return std * jax.random.normal(next(keys), shape, jnp.float32)

    L, D = DEPTH, D_MODEL
    G, N, P = SSM_GROUPS, SSM_STATE, SSM_GROUP_CH
    x = normal((BATCH, SEQ, D), 1.0)
    c = normal((BATCH, D), 1.0)
    ctx = normal((BATCH, CTX_LEN, D), 1.0)
    c_ctx = normal((D,), 1.0)
    norm_g = 1.0 + normal((L, D), 0.02)
    w_mod = normal((L, D, 3 * D), 0.5 * D ** -0.5)
    b_mod = normal((L, 3 * D), 0.02)
    w_in = normal((L, D, IN_WIDTH), D ** -0.5)
    ssm_lam_re = -0.5 + normal((L, 2, G, N), 0.01)
    ssm_lam_im = math.pi * jnp.arange(N, dtype=jnp.float32) + normal((L, 2, G, N), 0.01)
    ssm_log_dt = jax.random.uniform(next(keys), (L, 2, G), jnp.float32, math.log(DT_MIN), math.log(DT_MAX))
    ssm_b_re = normal((L, 2, G, N, P), (2.0 * P) ** -0.5)
    ssm_b_im = normal((L, 2, G, N, P), (2.0 * P) ** -0.5)
    ssm_c_re = normal((L, 2, G, P, N), 0.5 ** 0.5)
    ssm_c_im = normal((L, 2, G, P, N), 0.5 ** 0.5)
    ssm_d = normal((L, SSM_WIDTH), 1.0)
    ssm_w_glu = normal((L, SSM_WIDTH, SSM_WIDTH), SSM_WIDTH ** -0.5)
    gla_w_a = normal((L, 2, GLA_RANK, GLA_KW), GLA_RANK ** -0.5)
    gla_b_a = normal((L, 2, GLA_KW), 0.1)
    gla_norm_g = 1.0 + normal((L, GLA_DV), 0.02)
    attn_q_g = 1.0 + normal((L, HEAD_DIM), 0.02)
    attn_k_g = 1.0 + normal((L, HEAD_DIM), 0.02)
    w_proj_ssm = normal((L, SSM_WIDTH, D), SSM_WIDTH ** -0.5)
    w_proj_gla = normal((L, GLA_VW, D), GLA_VW ** -0.5)
    w_proj_attn = normal((L, ATTN_QW, D), ATTN_QW ** -0.5)
    w_out = normal((L, D, D), D ** -0.5)
    final_g = 1.0 + normal((D,), 0.02)
    return {"x": x, "c": c, "ctx": ctx, "c_ctx": c_ctx, "norm_g": norm_g, "w_mod": w_mod, "b_mod": b_mod,
            "w_in": w_in, "ssm_lam_re": ssm_lam_re, "ssm_lam_im": ssm_lam_im, "ssm_log_dt": ssm_log_dt,
            "ssm_b_re": ssm_b_re, "ssm_b_im": ssm_b_im, "ssm_c_re": ssm_c_re, "ssm_c_im": ssm_c_im,
            "ssm_d": ssm_d, "ssm_w_glu": ssm_w_glu, "gla_w_a": gla_w_a, "gla_b_a": gla_b_a,
            "gla_norm_g": gla_norm_g, "attn_q_g": attn_q_g, "attn_k_g": attn_k_g,
            "w_proj_ssm": w_proj_ssm, "w_proj_gla": w_proj_gla, "w_proj_attn": w_proj_attn,
            "w_out": w_out, "final_g": final_g}


def reference(x, c, ctx, c_ctx, norm_g, w_mod, b_mod, w_in, ssm_lam_re, ssm_lam_im, ssm_log_dt,
              ssm_b_re, ssm_b_im, ssm_c_re, ssm_c_im, ssm_d, ssm_w_glu, gla_w_a, gla_b_a, gla_norm_g,
              attn_q_g, attn_k_g, w_proj_ssm, w_proj_gla, w_proj_attn, w_out, final_g):
    T = x.shape[1]
    rows = T // GRID_W
    cos, sin = axial_rotary(rows)
    xc = ctx
    for l in range(DEPTH):
        ctx_out = l < DEPTH - 1
        mod = jax.nn.silu(c) @ w_mod[l] + b_mod[l]
        mod_c = jax.nn.silu(c_ctx)[None] @ w_mod[l] + b_mod[l]
        shift, scale, gate = jnp.split(mod, 3, axis=-1)
        shift_c, scale_c, gate_c = jnp.split(mod_c, 3, axis=-1)
        h = rms_norm(x, norm_g[l]) * (1.0 + scale[:, None]) + shift[:, None]
        hc = rms_norm(xc, norm_g[l]) * (1.0 + scale_c[:, None]) + shift_c[:, None]
        (su, sz, gq, gk, gv, gz, glr, aq, ak, av, az, mg) = split_columns(h @ w_in[l])
        (su_c, sz_c, gq_c, gk_c, gv_c, gz_c, glr_c, aq_c, ak_c, av_c, az_c, mg_c) = split_columns(hc @ w_in[l])
        s_l, s_c = s5_branch(su, su_c, ssm_lam_re[l], ssm_lam_im[l], ssm_log_dt[l], ssm_b_re[l], ssm_b_im[l],
                             ssm_c_re[l], ssm_c_im[l], ssm_d[l], ctx_out)
        g_l, g_c = gla_branch(gq, gk, gv, glr, gq_c, gk_c, gv_c, glr_c, gla_w_a[l], gla_b_a[l],
                              gla_norm_g[l], ctx_out)
        a_l, a_c = attention_branch(aq, ak, av, aq_c, ak_c, av_c, attn_q_g[l], attn_k_g[l], cos, sin, ctx_out)
        out = merge_branches(s_l, sz, g_l, gz, a_l, az, mg, ssm_w_glu[l], w_proj_ssm[l], w_proj_gla[l],
                             w_proj_attn[l], w_out[l])
        x = x + gate[:, None] * out
        if ctx_out:
            out_c = merge_branches(s_c, sz_c, g_c, gz_c, a_c, az_c, mg_c, ssm_w_glu[l], w_proj_ssm[l],
                                   w_proj_gla[l], w_proj_attn[l], w_out[l])
            xc = xc + gate_c[:, None] * out_c
    return rms_norm(x, final_g)
```

```cpp
#include <hip/hip_runtime.h>
#include <hip/hip_bf16.h>
#include <cstdio>
#include <cstdint>

#define GAS __attribute__((address_space(1)))
#define LAS __attribute__((address_space(3)))
typedef unsigned short bf16;
typedef unsigned v4u __attribute__((ext_vector_type(4)));
typedef unsigned v2u __attribute__((ext_vector_type(2)));
typedef float f32x4 __attribute__((ext_vector_type(4)));
typedef float f32x2 __attribute__((ext_vector_type(2)));
typedef short bf16x8 __attribute__((ext_vector_type(8)));
typedef short bf16x4 __attribute__((ext_vector_type(4)));
typedef GAS unsigned gu32;

constexpr int DM = 4096, NB = 2, TL = 4096, TC = 256, RPB = TC + TL  , MROWS = NB * RPB  ;
constexpr int NIN = 22560, NP = 22784  ;
constexpr int C_SU = 0, C_SZ = 1024, C_GQ = 2048, C_GK = 2560, C_GV = 3072, C_GZ = 4096, C_AQ = 5120, C_AK = 7168, C_AV = 7680, C_AZ = 8192, C_MG = 10240, C_LR = 22528;
constexpr int SSM_W = 1024, GLA_KW = 512, GLA_VW = 1024, ATT_QW = 2048, ATT_KVW = 512;
constexpr float EPS = 1e-6f;
constexpr int NWAVES = 8, NTHR = 512;
constexpr int GCH = 32  , GNCH = RPB / GCH  , GNCTX = TC / GCH  ;
constexpr int SCH = 16  , SNCH = RPB / SCH  ;

enum { I_X = 0, I_C, I_CTX, I_CCTX, I_NORMG, I_WMOD, I_BMOD, I_WIN, I_LAMRE, I_LAMIM, I_LOGDT, I_BRE, I_BIM, I_CRE, I_CIM, I_SSMD, I_WGLU, I_GWA, I_GBA, I_GNORM,
       I_AQG, I_AKG, I_WPS, I_WPG, I_WPA, I_WOUT, I_FINALG, N_IN };

constexpr size_t al256(size_t x) { return (x + 255) / 256 * 256; }
constexpr size_t WS_CTL = 0, CTL_ZERO_BYTES = 1u << 20;
constexpr size_t WS_MODP = WS_CTL + CTL_ZERO_BYTES;
constexpr size_t WS_MOD = WS_MODP + al256((size_t)2 * 32 * 3 * 12288 * 4);
constexpr size_t WS_ROPE = WS_MOD + al256((size_t)2 * 3 * 12288 * 4);
constexpr size_t WS_WIN = WS_ROPE + al256((size_t)2 * 64 * 32 * 4);
constexpr size_t WS_WGLU = WS_WIN + al256((size_t)2 * NP * DM * 2);
constexpr size_t WS_WPS = WS_WGLU + al256((size_t)2 * 1024 * 1024 * 2);
constexpr size_t WS_WPG = WS_WPS + al256((size_t)2 * 4096 * 1024 * 2);
constexpr size_t WS_WPA = WS_WPG + al256((size_t)2 * 4096 * 1024 * 2);
constexpr size_t WS_WO = WS_WPA + al256((size_t)2 * 4096 * 2048 * 2);
constexpr size_t WS_TG = WS_WO + al256((size_t)2 * 4096 * 4096 * 2);
constexpr size_t WS_WT = WS_TG + al256((size_t)2 * 2 * 64 * 256 * 384 * 2);
constexpr size_t WS_L16 = WS_WT + al256((size_t)2 * 2 * 64 * 128 * 256 * 2);
constexpr size_t WS_H = WS_L16 + al256((size_t)2 * 2 * 64 * 64 * 2 * 4);
constexpr size_t WS_P = WS_H + al256((size_t)MROWS * DM * 2);
constexpr size_t WS_X1 = WS_P + al256((size_t)MROWS * NP * 2);
constexpr size_t WS_QN = WS_X1 + al256((size_t)MROWS * DM * 4);
constexpr size_t WS_KN = WS_QN + al256((size_t)MROWS * 2048 * 2);
constexpr size_t WS_E = WS_KN + al256((size_t)MROWS * 512 * 2);
constexpr size_t WS_HS = WS_E + al256((size_t)128 * SNCH * 128 * 4);
constexpr size_t WS_YF = WS_HS + al256((size_t)128 * SNCH * 128 * 2);
constexpr size_t WS_GB = WS_YF + al256((size_t)MROWS * 1024 * 4);
constexpr size_t WS_SB = WS_GB + al256((size_t)MROWS * 1024 * 2);
constexpr size_t WS_GL = WS_SB + al256((size_t)MROWS * 1024 * 2);
constexpr size_t WS_AT = WS_GL + al256((size_t)MROWS * 1024 * 2);
constexpr size_t WS_QH = WS_AT + al256((size_t)MROWS * 2048 * 2);
constexpr size_t WS_KHT = WS_QH + al256((size_t)2 * MROWS * 512 * 2);
constexpr size_t WS_AM = WS_KHT + al256((size_t)2 * MROWS * 512 * 2);
constexpr size_t WS_VT = WS_AM + al256((size_t)2 * 272 * 8 * 32 * 32 * 2);
constexpr size_t WS_DEC = WS_VT + al256((size_t)272 * 8 * 128 * 32 * 2);
constexpr size_t WS_GO = WS_DEC + al256((size_t)2 * 272 * 512 * 4);
constexpr size_t WS_MACC = WS_GO + al256((size_t)2 * MROWS * 1024 * 4);
constexpr size_t WS_MRG = WS_MACC + al256((size_t)MROWS * DM * 4);
constexpr size_t WS_VN = WS_MRG + al256((size_t)MROWS * DM * 2);
constexpr size_t WS_ATG = WS_VN + al256((size_t)MROWS * 512 * 2);
constexpr size_t WS_ACAT = WS_ATG + al256((size_t)MROWS * 2048 * 2);
constexpr size_t WS_WCAT = WS_ACAT + al256((size_t)MROWS * DM * 2);
constexpr size_t WS_PART = WS_WCAT + al256((size_t)2 * DM * DM * 2);
constexpr size_t WS_UB = WS_PART + al256((size_t)8 * 512 * DM * 4);
constexpr size_t WS_PARTP = WS_UB + al256((size_t)MROWS * 1024 * 2);
constexpr size_t WS_END = WS_PARTP + al256((size_t)248 * 65536 * 4);

constexpr int CW_TMO = 0, CW_CODE = 1, CW_QUEUE = 1024, CW_PQ = 1536, CW_TQ = 2048, CW_BAR = 4096, CW_MQ = 131072  ;

constexpr int RING_OFF = 0, RING_BYTES = 147456;
constexpr int LDSCTL_OFF = RING_BYTES, MISC_OFF = LDSCTL_OFF + 320, INTAB_OFF = LDSCTL_OFF + 512;
constexpr int LDS_BYTES = 148480;

#define RLX_AGENT __ATOMIC_RELAXED, __HIP_MEMORY_SCOPE_AGENT
#define LDS_WAIT() asm volatile("s_waitcnt lgkmcnt(0)" ::: "memory")
#define VM_WAIT() asm volatile("s_waitcnt vmcnt(0)" ::: "memory")
__device__ __forceinline__ unsigned f2bf(float f) { unsigned u = __builtin_bit_cast(unsigned, f); return (u + 0x7fffu + ((u >> 16) & 1u)) >> 16; }
__device__ __forceinline__ unsigned pk2(float lo, float hi) { return f2bf(lo) | (f2bf(hi) << 16); }
__device__ __forceinline__ float bf2f(unsigned short b) { return __builtin_bit_cast(float, (unsigned)b << 16); }
__device__ __forceinline__ float bflo(unsigned w) { return __builtin_bit_cast(float, w << 16); }
__device__ __forceinline__ float bfhi(unsigned w) { return __builtin_bit_cast(float, w & 0xffff0000u); }
__device__ __forceinline__ float sigmoidf_(float x) { return __builtin_amdgcn_rcpf(1.0f + __builtin_amdgcn_exp2f(-1.4426950408889634f * x)); }
__device__ __forceinline__ float siluf_(float x) { return x * __builtin_amdgcn_rcpf(1.0f + __builtin_amdgcn_exp2f(-1.4426950408889634f * x)); }
__device__ __forceinline__ float gelu_tanh(float x) {
    const float u = 1.5957691216057308f * (x + 0.044715f * x * x * x); return x * __builtin_amdgcn_rcpf(1.0f + __builtin_amdgcn_exp2f(-1.4426950408889634f * u)); }
__device__ __forceinline__ float wave_sum(float v) {
#pragma unroll
    for (int o = 1; o < 64; o <<= 1) v += __shfl_xor(v, o);
    return v;
}
namespace pg8 {
#define PG8_LAS __attribute__((address_space(3)))
typedef unsigned short bf16_t;
typedef unsigned u32x4 __attribute__((ext_vector_type(4)));
constexpr int BM = 256, BK = 64, HALF = 128, HTB = HALF * BK * 2  , STAGE_BYTES = 8 * HTB, NXCD = 8, WGM = 8;

__host__ __device__ __forceinline__ int lds_byte(int r, int c) { const int st = (r >> 4) * 2 + (c >> 5), rr = r & 15, cc = c & 31, ob = rr * 64 + cc * 2; return st * 1024 + (ob ^ (((ob >> 9) & 1) << 5)); }
__host__ __device__ __forceinline__ void stage_rc(int b, int& R, int& C) { const int st = b / 1024, sb = b % 1024, swz = sb ^ (((sb >> 9) & 1) << 5); R = (st >> 1) * 16 + swz / 64; C = (st & 1) * 32 + (swz % 64) / 2; }
__host__ __device__ __forceinline__ int perm32(int rho) { const int n = rho >> 4, i = rho & 15; return 8 * (i >> 2) + 4 * n + (i & 3); }

struct Unit { int pm, pn, ko, aux; };
struct Gemm { const bf16_t* A; const bf16_t* Bt; int M, N, K, lda, ldb; };

struct StaticOrder {
    int nM, nN, nwg, G, c;
    __host__ __device__ void init(int M, int N, int G_, int c_) { nM = M / BM; nN = N / BM; nwg = nM * nN; G = G_; c = c_; }
    __host__ __device__ bool next(int i, Unit& u) const { return at((long)i * G + c, u); }
    __host__ __device__ bool at(long L, Unit& u) const {
        if (L >= nwg) return false;
        int wgid = (int)L; { const int q = nwg / NXCD, r = nwg % NXCD, xcd = wgid % NXCD, off = wgid / NXCD; wgid = (xcd < r ? xcd * (q + 1) : r * (q + 1) + (xcd - r) * q) + off; }
        const int nig = WGM * nN, gid = wgid / nig, fm = gid * WGM, gsz = (nM - fm) < WGM ? (nM - fm) : WGM;
        u.pm = fm + ((wgid % nig) % gsz); u.pn = (wgid % nig) / gsz; u.ko = 0; u.aux = 0; return true;
    }
    __device__ __forceinline__ void a_ready(const Unit&) const {}
    __device__ __forceinline__ void done(const Unit&) const {}
};

struct RowOrder {
    StaticOrder b; int lat;
    __host__ __device__ void init(int M, int N, int G_, int c_, int lat_) { lat = lat_; b.init(lat_ ? M - 512 : M, N, G_, c_); }
    __host__ __device__ bool next(int i, Unit& u) const { if (!b.next(i, u)) return false; if (lat) u.pm += 1 + (u.pm >= 16 ? 1 : 0); return true; }
    __device__ __forceinline__ void a_ready(const Unit&) const {}
    __device__ __forceinline__ void done(const Unit&) const {}
};

struct InProjOrder {
    StaticOrder b; int lat, G, c, imax;
    __host__ __device__ void init(int M, int N, int G_, int c_, int lat_, int imax_) { lat = lat_; G = G_; c = c_; imax = imax_; b.init(lat_ ? M - 512 : M, N, G_, c_); }
    __host__ __device__ bool next(int i, Unit& u) const { if (i >= imax) return false; return at((long)i * G + c, u); }
    __host__ __device__ bool at(long L, Unit& u) const {
        if (!lat) return b.at(L, u);
        if (b.at(L, u)) { u.pm += 1 + (u.pm >= 16 ? 1 : 0); return true; }
        const int e = (int)(L - b.nwg); if (e >= 30) return false;
        const int t = e % 15; u.pm = (e / 15) * 17; u.pn = t < 4 ? t : (t < 10 ? t + 6 : (t < 14 ? t + 18 : 88)); u.ko = 0; u.aux = 0; return true;
    }
    __device__ __forceinline__ void a_ready(const Unit&) const {}
    __device__ __forceinline__ void done(const Unit&) const {}
};

struct InProjSplitOrder {
    InProjOrder o; int G, c;
    __host__ __device__ void init(int M, int N, int G_, int c_) { G = G_; c = c_; o.init(M, N, G_, c_, 1, 1 << 30); }
    __host__ __device__ bool next(int i, Unit& u) const { const int s = i * G + c; if (s >= 248) return false; if (!o.at(2816 + (s >> 2), u)) return false; u.ko = (s & 3) * 1024; u.aux = s; return true; }
    __device__ __forceinline__ void a_ready(const Unit&) const {}
    __device__ __forceinline__ void done(const Unit&) const {}
};
struct EpiPartial {
    static constexpr bool KHOOK = false;
    static constexpr bool PERM = false, AFTER_DRAIN = false;
    float* PART;
    __device__ __forceinline__ void operator()(const f32x4 (&acc)[2][2][4][2], const Unit& u, int wr, int wc, int fr, int fq) const {
        float* dst = PART + (size_t)u.aux * 65536; const int rr0 = wr * 64 + fr, col0 = wc * 32 + 4 * fq;
#pragma unroll
        for (int ai = 0; ai < 2; ++ai)
#pragma unroll
            for (int m = 0; m < 4; ++m) { const int off = (rr0 + ai * HALF + m * 16) * 256 + col0;
#pragma unroll
                for (int bj = 0; bj < 2; ++bj)
#pragma unroll
                    for (int n = 0; n < 2; ++n) *(f32x4*)(dst + off + bj * HALF + n * 16) = acc[ai][bj][m][n]; }
    }
};

struct CtxSplitOrder {
    int G, c;
    __host__ __device__ void init(int G_, int c_) { G = G_; c = c_; }
    __host__ __device__ bool next(int i, Unit& u) const { const int L = i * G + c; if (L >= 256) return false; u.pm = (L >> 7) * 17; u.pn = (L >> 3) & 15; u.ko = (L & 7) * 512; u.aux = 0; return true; }
    __device__ __forceinline__ void a_ready(const Unit&) const {}
    __device__ __forceinline__ void done(const Unit&) const {}
};

__device__ __forceinline__ unsigned cvt_pk_bf16(float lo, float hi) { unsigned r; asm volatile("v_cvt_pk_bf16_f32 %0, %1, %2" : "=v"(r) : "v"(lo), "v"(hi)); return r; }
__device__ __forceinline__ u32x4 pack8(const f32x4 v0, const f32x4 v1) { u32x4 w; w.x = cvt_pk_bf16(v0[0], v0[1]); w.y = cvt_pk_bf16(v0[2], v0[3]); w.z = cvt_pk_bf16(v1[0], v1[1]); w.w = cvt_pk_bf16(v1[2], v1[3]); return w; }
__device__ __forceinline__ void unpack8(const u32x4 w, f32x4& v0, f32x4& v1) { v0 = (f32x4){bflo(w.x), bfhi(w.x), bflo(w.y), bfhi(w.y)}; v1 = (f32x4){bflo(w.z), bfhi(w.z), bflo(w.w), bfhi(w.w)}; }

struct EpiInProj {
    static constexpr bool KHOOK = false;
    static constexpr bool PERM = true, AFTER_DRAIN = false;
    bf16_t* P; bf16_t* UB;
    __device__ __forceinline__ void operator()(const f32x4 (&acc)[2][2][4][2], const Unit& u, int wr, int wc, int fr, int fq) const {
        const int pn = u.pn;
        const int act = (pn >= 40 && pn < 88) ? 2 : (((pn >= 4 && pn < 8) || (pn >= 16 && pn < 20) || (pn >= 32 && pn < 40)) ? 1 : 0);
        const int row0 = u.pm * BM + wr * 64 + fr, col0 = pn * BM + wc * 32 + 8 * fq;
#pragma unroll
        for (int ai = 0; ai < 2; ++ai)
#pragma unroll
            for (int m = 0; m < 4; ++m) { bf16_t* rowp = P + (size_t)(row0 + ai * HALF + m * 16) * NP + col0;
                if (pn < 4) {
                    const int bb = u.pm / 17, jj = (u.pm % 17) * BM + wr * 64 + fr + ai * HALF + m * 16;
#pragma unroll
                    for (int bj = 0; bj < 2; ++bj) { const int c = col0 + bj * HALF;
                        *(u32x4*)(UB + (((size_t)bb * 64 + (c >> 4)) * RPB + jj) * 16 + (c & 15)) = pack8(acc[ai][bj][m][0], acc[ai][bj][m][1]); }
                    continue; }
#pragma unroll
                for (int bj = 0; bj < 2; ++bj) { f32x4 v0 = acc[ai][bj][m][0], v1 = acc[ai][bj][m][1];
                    if (act == 1) {
#pragma unroll
                        for (int j = 0; j < 4; ++j) { v0[j] = siluf_(v0[j]); v1[j] = siluf_(v1[j]); } }
                    else if (act == 2) {
#pragma unroll
                        for (int j = 0; j < 4; ++j) { v0[j] = sigmoidf_(v0[j]); v1[j] = sigmoidf_(v1[j]); } }
                    *(u32x4*)(rowp + bj * HALF) = pack8(v0, v1); } }
    }
};
struct EpiGlu {
    static constexpr bool KHOOK = false;
    static constexpr bool PERM = true, AFTER_DRAIN = false;
    const bf16_t* GBp; const bf16_t* P; bf16_t* SBp;
    __device__ __forceinline__ void operator()(const f32x4 (&acc)[2][2][4][2], const Unit& u, int wr, int wc, int fr, int fq) const {
        const int row0 = u.pm * BM + wr * 64 + fr, col0 = u.pn * BM + wc * 32 + 8 * fq;
#pragma unroll
        for (int ai = 0; ai < 2; ++ai)
#pragma unroll
            for (int m = 0; m < 4; ++m) { const size_t row = (size_t)(row0 + ai * HALF + m * 16);
#pragma unroll
                for (int bj = 0; bj < 2; ++bj) { const int col = col0 + bj * HALF;
                    f32x4 g0, g1, z0, z1; unpack8(*(const u32x4*)(GBp + row * 1024 + col), g0, g1); unpack8(*(const u32x4*)(P + row * NP + C_SZ + col), z0, z1);
                    f32x4 v0 = acc[ai][bj][m][0], v1 = acc[ai][bj][m][1];
#pragma unroll
                    for (int j = 0; j < 4; ++j) { v0[j] = g0[j] * sigmoidf_(v0[j]) * z0[j]; v1[j] = g1[j] * sigmoidf_(v1[j]) * z1[j]; }
                    *(u32x4*)(SBp + row * DM + col) = pack8(v0, v1); } }
    }
};
struct EpiProjCat {
    static constexpr bool KHOOK = true;
    static constexpr bool PERM = true, AFTER_DRAIN = false;
    const bf16_t* P; bf16_t* MRG;
    __device__ __forceinline__ void khook(f32x4 (&acc)[2][2][4][2], const Unit& u, int t, int wr, int wc, int fr, int fq) const {
        const int gn = C_MG + (t == 16 ? 0 : 4096);
        int fr_ = fr, fq_ = fq; asm volatile("" : "+v"(fr_), "+v"(fq_));
        const int row0 = u.pm * BM + wr * 64 + fr_, col0 = u.pn * BM + wc * 32 + 8 * fq_;
#pragma unroll
        for (int ai = 0; ai < 2; ++ai)
#pragma unroll
            for (int mp = 0; mp < 2; ++mp) {
                u32x4 gnum[2][2], gden[2][2];
#pragma unroll
                for (int mm = 0; mm < 2; ++mm)
#pragma unroll
                    for (int bj = 0; bj < 2; ++bj) { const bf16_t* gp = P + (size_t)(row0 + ai * HALF + (2 * mp + mm) * 16) * NP + gn + col0 + bj * HALF; gnum[mm][bj] = *(const u32x4*)gp; gden[mm][bj] = *(const u32x4*)(gp + 4096); }
#pragma unroll
                for (int mm = 0; mm < 2; ++mm)
#pragma unroll
                    for (int bj = 0; bj < 2; ++bj) { const int m = 2 * mp + mm; f32x4 n0, n1, d0, d1; unpack8(gnum[mm][bj], n0, n1); unpack8(gden[mm][bj], d0, d1);
#pragma unroll
                        for (int j = 0; j < 4; ++j) { acc[ai][bj][m][0][j] *= n0[j] * __builtin_amdgcn_rcpf(d0[j]); acc[ai][bj][m][1][j] *= n1[j] * __builtin_amdgcn_rcpf(d1[j]); } }
                asm volatile("" ::: "memory");
            }
    }
    __device__ __forceinline__ void operator()(const f32x4 (&acc)[2][2][4][2], const Unit& u, int wr, int wc, int fr, int fq) const {
        const int row0 = u.pm * BM + wr * 64 + fr, col0 = u.pn * BM + wc * 32 + 8 * fq;
#pragma unroll
        for (int ai = 0; ai < 2; ++ai)
#pragma unroll
            for (int m = 0; m < 4; ++m) { const size_t row = (size_t)(row0 + ai * HALF + m * 16);
#pragma unroll
                for (int bj = 0; bj < 2; ++bj) { const int col = col0 + bj * HALF;
                    f32x4 g0, g1; unpack8(*(const u32x4*)(P + row * NP + C_MG + 8192 + col), g0, g1);
                    *(u32x4*)(MRG + row * DM + col) = pack8(acc[ai][bj][m][0] * g0, acc[ai][bj][m][1] * g1); } }
    }
};
struct EpiOut {
    static constexpr bool KHOOK = false;
    static constexpr bool PERM = false, AFTER_DRAIN = false;
    const float* xin; const float* cin; float* X1; float* out; const float* MODl; int layer;
    __device__ __forceinline__ void operator()(const f32x4 (&acc)[2][2][4][2], const Unit& u, int wr, int wc, int fr, int fq) const {
        const int b = u.pm / 17, jt = u.pm % 17; const bool isctx = (jt == 0);
        if (layer == 1 && isctx) return;
        const float* src; float* dst;
        if (layer == 0) { src = isctx ? cin + (size_t)b * TC * DM : xin + ((size_t)b * TL + (size_t)(jt - 1) * 256) * DM; dst = X1 + (size_t)u.pm * 256 * DM; }
        else { src = X1 + (size_t)u.pm * 256 * DM; dst = out + ((size_t)b * TL + (size_t)(jt - 1) * 256) * DM; }
        const float* gv = MODl + (size_t)(isctx ? 2 : b) * 12288 + 8192;
        const int rr0 = wr * 64 + fr, col0 = u.pn * BM + wc * 32 + 4 * fq;
        f32x4 gt[2][2];
#pragma unroll
        for (int bj = 0; bj < 2; ++bj)
#pragma unroll
            for (int n = 0; n < 2; ++n) gt[bj][n] = *(const f32x4*)(gv + col0 + bj * HALF + n * 16);
#pragma unroll
        for (int ai = 0; ai < 2; ++ai)
#pragma unroll
            for (int m = 0; m < 4; ++m) { const size_t off = (size_t)(rr0 + ai * HALF + m * 16) * DM + col0;
#pragma unroll
                for (int bj = 0; bj < 2; ++bj)
#pragma unroll
                    for (int n = 0; n < 2; ++n) { const f32x4 xo = *(const f32x4*)(src + off + bj * HALF + n * 16);
                        *(f32x4*)(dst + off + bj * HALF + n * 16) = xo + gt[bj][n] * acc[ai][bj][m][n]; } }
    }
};


struct EpiOutCtxPartial {
    static constexpr bool KHOOK = false;
    static constexpr bool PERM = false, AFTER_DRAIN = false;
    float* PART;
    __device__ __forceinline__ void operator()(const f32x4 (&acc)[2][2][4][2], const Unit& u, int wr, int wc, int fr, int fq) const {
        float* dst = PART + ((size_t)(u.ko >> 9) * 512 + (size_t)(u.pm / 17) * 256) * DM;
        const int rr0 = wr * 64 + fr, col0 = u.pn * BM + wc * 32 + 4 * fq;
#pragma unroll
        for (int ai = 0; ai < 2; ++ai)
#pragma unroll
            for (int m = 0; m < 4; ++m) { const size_t off = (size_t)(rr0 + ai * HALF + m * 16) * DM + col0;
#pragma unroll
                for (int bj = 0; bj < 2; ++bj)
#pragma unroll
                    for (int n = 0; n < 2; ++n) *(f32x4*)(dst + off + bj * HALF + n * 16) = acc[ai][bj][m][n]; }
    }
};
template <class Epi, class Sched, bool ALIGN_EPI = false, bool SP2 = false>
__device__ __forceinline__ void gemm_phase(PG8_LAS unsigned char* lds, const Gemm g, const Sched& S, const Epi& E, const int tid_in) {
    const int tid = tid_in  , wid = __builtin_amdgcn_readfirstlane(tid >> 6), lane = tid & 63, wr = wid >> 2, wc = wid & 3, fr = lane & 15, fq = lane >> 4;
    const int K = g.K, nt = K / BK;
    unsigned voffA[2], voffB[2];
#pragma unroll
    for (int i = 0; i < 2; ++i) { int R, C; stage_rc(tid * 16 + i * 8192, R, C); const int Rb = Epi::PERM ? ((R & ~31) + perm32(R & 31)) : R;
        voffA[i] = (unsigned)(R * g.lda + C) * 2u; voffB[i] = (unsigned)(Rb * g.ldb + C) * 2u; }
    const size_t kstep = (size_t)(BK * 2);
    const size_t hstepA = (size_t)HALF * g.lda * 2, hstepB = (size_t)HALF * g.ldb * 2;
    const size_t tstepA = 2 * hstepA, tstepB = 2 * hstepB;
    const unsigned ldsw = (unsigned)wid * 1024u;
    const int aoff = lds_byte(wr * 64 + fr, fq * 8), boff = lds_byte(wc * 32 + fr, fq * 8);
#define PG8_SA(b, h) (((b) * 2 + (h)) * HTB)
#define PG8_SB(b, h) ((4 + (b) * 2 + (h)) * HTB)
#define PG8_STAGE(bufoff, gbase, voff) do { _Pragma("unroll") for (int _i = 0; _i < 2; ++_i) \
        __builtin_amdgcn_global_load_lds((const unsigned*)((const char*)(gbase) + (voff)[_i]), (PG8_LAS unsigned*)(lds + (bufoff) + ldsw + _i * 8192), 16, 0, 0); } while (0)
#define PG8_LDA(dst, b, h) do { _Pragma("unroll") for (int m = 0; m < 4; ++m) _Pragma("unroll") for (int k = 0; k < 2; ++k) dst[m][k] = *(const PG8_LAS bf16x8*)(lds + PG8_SA(b, h) + aoff + m * 2048 + k * 1024); } while (0)
#define PG8_LDB(dst, b, h) do { _Pragma("unroll") for (int n = 0; n < 2; ++n) _Pragma("unroll") for (int k = 0; k < 2; ++k) dst[n][k] = *(const PG8_LAS bf16x8*)(lds + PG8_SB(b, h) + boff + n * 2048 + k * 1024); } while (0)
#define PG8_MMA(ai, bj, At, Bt) do { __builtin_amdgcn_s_setprio(1); _Pragma("unroll") for (int m = 0; m < 4; ++m) _Pragma("unroll") for (int n = 0; n < 2; ++n) _Pragma("unroll") for (int k = 0; k < 2; ++k) \
        acc[ai][bj][m][n] = __builtin_amdgcn_mfma_f32_16x16x32_bf16(Bt[n][k], At[m][k], acc[ai][bj][m][n], 0, 0, 0); __builtin_amdgcn_s_setprio(0); } while (0)
#define PG8_WAIT_V(n) asm volatile("s_waitcnt vmcnt(" #n ")" ::: "memory")
#define PG8_WAIT_L(n) asm volatile("s_waitcnt lgkmcnt(" #n ")" ::: "memory")
#define PG8_BAR __builtin_amdgcn_s_barrier()
#define PG8_SCHED __builtin_amdgcn_sched_barrier(0)
    Unit cur, nxt; int ui = 0;
    if (!S.next(0, cur)) return;
    f32x4 acc[2][2][4][2];
#pragma unroll
    for (int a = 0; a < 2; ++a)
#pragma unroll
        for (int b = 0; b < 2; ++b)
#pragma unroll
            for (int m = 0; m < 4; ++m)
#pragma unroll
                for (int n = 0; n < 2; ++n) acc[a][b][m][n] = (f32x4){0.f, 0.f, 0.f, 0.f};
    bf16x8 At[4][2], B0[2][2], B1[2][2];
    const char* cA = (const char*)g.A + (size_t)cur.pm * tstepA + (size_t)cur.ko * 2; const char* cB = (const char*)g.Bt + (size_t)cur.pn * tstepB + (size_t)cur.ko * 2;
    S.a_ready(cur);
    if constexpr (SP2) {
        PG8_STAGE(PG8_SB(0, 0), cB, voffB); PG8_STAGE(PG8_SB(0, 1), cB + hstepB, voffB); PG8_STAGE(PG8_SA(0, 0), cA, voffA); PG8_STAGE(PG8_SA(0, 1), cA + hstepA, voffA);
        if (wr == 1) PG8_BAR;
        PG8_WAIT_V(2); PG8_BAR;
        PG8_STAGE(PG8_SB(1, 0), cB + kstep, voffB); PG8_STAGE(PG8_SA(1, 0), cA + kstep, voffA); PG8_STAGE(PG8_SB(1, 1), cB + hstepB + kstep, voffB);
        PG8_WAIT_V(6); PG8_BAR;
    } else {
        PG8_STAGE(PG8_SB(0, 0), cB, voffB); PG8_STAGE(PG8_SA(0, 0), cA, voffA); PG8_STAGE(PG8_SB(0, 1), cB + hstepB, voffB); PG8_STAGE(PG8_SA(0, 1), cA + hstepA, voffA);
        if (wr == 1) PG8_BAR;
        PG8_WAIT_V(4); PG8_BAR;
        PG8_STAGE(PG8_SB(1, 0), cB + kstep, voffB); PG8_STAGE(PG8_SA(1, 0), cA + kstep, voffA); PG8_STAGE(PG8_SB(1, 1), cB + hstepB + kstep, voffB);
        PG8_WAIT_V(6); PG8_BAR;
    }
    for (;;) {
        const bool has_next = S.next(ui + 1, nxt);
        const char* nA = has_next ? (const char*)g.A + (size_t)nxt.pm * tstepA + (size_t)nxt.ko * 2 : cA; const char* nB = has_next ? (const char*)g.Bt + (size_t)nxt.pn * tstepB + (size_t)nxt.ko * 2 : cB;
        for (int t = 0; t < nt; t += 2) {
            const bool last = (t == nt - 2);
            const char* a1 = cA + (size_t)(t + 1) * kstep;
            const char* a2 = last ? nA : cA + (size_t)(t + 2) * kstep; const char* b2 = last ? nB : cB + (size_t)(t + 2) * kstep;
            const char* a3 = a2 + kstep; const char* b3 = b2 + kstep;
            if (last && has_next) S.a_ready(nxt);
            if constexpr (Epi::KHOOK) { if (t == 16 || t == 32) E.khook(acc, cur, t, wr, wc, fr, fq); }
            if constexpr (SP2) {
            PG8_LDB(B0, 0, 0); PG8_LDB(B1, 0, 1); PG8_SCHED; PG8_LDA(At, 0, 0); PG8_STAGE(PG8_SA(1, 1), a1 + hstepA, voffA);
            PG8_WAIT_V(8); PG8_WAIT_L(0); PG8_BAR; PG8_MMA(0, 0, At, B0); PG8_MMA(0, 1, At, B1); PG8_BAR; PG8_SCHED;
            PG8_LDA(At, 0, 1); PG8_STAGE(PG8_SB(0, 0), b2, voffB); PG8_STAGE(PG8_SB(0, 1), b2 + hstepB, voffB); PG8_STAGE(PG8_SA(0, 0), a2, voffA);
            PG8_WAIT_V(8); PG8_WAIT_L(0); PG8_BAR; PG8_MMA(1, 0, At, B0); PG8_MMA(1, 1, At, B1); PG8_BAR; PG8_SCHED;
            PG8_LDB(B0, 1, 0); PG8_LDB(B1, 1, 1); PG8_SCHED; PG8_LDA(At, 1, 0); PG8_STAGE(PG8_SA(0, 1), a2 + hstepA, voffA);
            PG8_WAIT_V(8); PG8_WAIT_L(0); PG8_BAR; PG8_MMA(0, 0, At, B0); PG8_MMA(0, 1, At, B1); PG8_BAR; PG8_SCHED;
            PG8_LDA(At, 1, 1); PG8_STAGE(PG8_SB(1, 0), b3, voffB); PG8_STAGE(PG8_SB(1, 1), b3 + hstepB, voffB); PG8_STAGE(PG8_SA(1, 0), a3, voffA);
            PG8_WAIT_V(8); PG8_WAIT_L(0); PG8_BAR; PG8_MMA(1, 0, At, B0); PG8_MMA(1, 1, At, B1); PG8_BAR; PG8_SCHED;
            } else {
            PG8_LDB(B0, 0, 0); PG8_SCHED; PG8_LDA(At, 0, 0); PG8_STAGE(PG8_SA(1, 1), a1 + hstepA, voffA);
            PG8_WAIT_L(8); PG8_BAR; PG8_WAIT_L(0); PG8_MMA(0, 0, At, B0); PG8_BAR; PG8_SCHED;
            PG8_LDB(B1, 0, 1); PG8_STAGE(PG8_SB(0, 0), b2, voffB);
            PG8_BAR; PG8_WAIT_L(0); PG8_MMA(0, 1, At, B1); PG8_BAR;
            PG8_LDA(At, 0, 1); PG8_STAGE(PG8_SA(0, 0), a2, voffA);
            PG8_BAR; PG8_WAIT_L(0); PG8_MMA(1, 0, At, B0); PG8_BAR; PG8_SCHED;
            PG8_STAGE(PG8_SB(0, 1), b2 + hstepB, voffB);
            PG8_WAIT_V(6); PG8_BAR; PG8_MMA(1, 1, At, B1); PG8_BAR;
            PG8_LDB(B0, 1, 0); PG8_SCHED; PG8_LDA(At, 1, 0); PG8_STAGE(PG8_SA(0, 1), a2 + hstepA, voffA);
            PG8_WAIT_L(8); PG8_BAR; PG8_WAIT_L(0); PG8_MMA(0, 0, At, B0); PG8_BAR; PG8_SCHED;
            PG8_LDB(B1, 1, 1); PG8_STAGE(PG8_SB(1, 0), b3, voffB);
            PG8_BAR; PG8_WAIT_L(0); PG8_MMA(0, 1, At, B1); PG8_BAR;
            PG8_LDA(At, 1, 1); PG8_STAGE(PG8_SA(1, 0), a3, voffA);
            PG8_BAR; PG8_WAIT_L(0); PG8_MMA(1, 0, At, B0); PG8_BAR; PG8_SCHED;
            PG8_STAGE(PG8_SB(1, 1), b3 + hstepB, voffB);
            PG8_WAIT_V(6); PG8_BAR; PG8_MMA(1, 1, At, B1); PG8_BAR;
            }
        }
        if constexpr (ALIGN_EPI) { if (wr == 0) PG8_BAR; }
        if constexpr (!Epi::AFTER_DRAIN) { E(acc, cur, wr, wc, fr, fq); S.done(cur); }
        if (!has_next) break;
#pragma unroll
        for (int a = 0; a < 2; ++a)
#pragma unroll
            for (int b = 0; b < 2; ++b)
#pragma unroll
                for (int m = 0; m < 4; ++m)
#pragma unroll
                    for (int n = 0; n < 2; ++n) acc[a][b][m][n] = (f32x4){0.f, 0.f, 0.f, 0.f};
        cur = nxt; cA = nA; cB = nB; ++ui;
        if constexpr (ALIGN_EPI) { if (wr == 1) PG8_BAR; }
    }
    PG8_WAIT_V(0);
    if constexpr (!ALIGN_EPI) { if (wr == 0) PG8_BAR; }
    PG8_BAR;
    if constexpr (Epi::AFTER_DRAIN) { E.fused(acc, cur, wr, wc, fr, fq, lds, wid, lane); S.done(cur); }
#undef PG8_SA
#undef PG8_SB
#undef PG8_STAGE
#undef PG8_LDA
#undef PG8_LDB
#undef PG8_MMA
#undef PG8_WAIT_V
#undef PG8_WAIT_L
#undef PG8_BAR
#undef PG8_SCHED
}
}
namespace att {
using bf16 = __hip_bfloat16;
constexpr int D = 128, NW = 8, QBLK = 32, KVBLK = 64;
constexpr float SCALE = 0.088388347648318440f;
constexpr float THR = 8.f;
constexpr int SDEPTH = 2;
constexpr int LDQ = 2048, LDK = 512, LDV = 512, LDO = 2048;
constexpr size_t SHM_V = KVBLK * D * 2, SHM_K = KVBLK * D * 2, SHM_ATTN = 2 * SHM_V + 2 * SHM_K + NW * 64 * 4;
using bf16x8 = __attribute__((ext_vector_type(8))) short;
using s16x4  = __attribute__((ext_vector_type(4))) short;
using f32x16 = __attribute__((ext_vector_type(16))) float;
using f32x8  = __attribute__((ext_vector_type(8))) float;
using u32x4  = __attribute__((ext_vector_type(4))) unsigned;
#define KSWZ(row, colB) ((row) * 256 + ((colB) ^ (((row) & 7) << 4)))
#define SBAR() __builtin_amdgcn_sched_barrier(0)
__device__ __forceinline__ int crow(int r, int hi) { return (r & 3) + 8 * (r >> 2) + 4 * hi; }
__device__ __forceinline__ unsigned cvtpk(float lo, float hi) {
  unsigned r; asm volatile("v_cvt_pk_bf16_f32 %0, %1, %2" : "=v"(r) : "v"(lo), "v"(hi)); return r;
}
template <typename TIn> struct Stage;
template <> struct Stage<bf16>  { using T = bf16x8;
  __device__ static __forceinline__ T ld8(const bf16* p) { return *reinterpret_cast<const bf16x8*>(p); }
  __device__ static __forceinline__ bf16x8 tobf(T x) { return x; } };
__device__ __forceinline__ void partialSM(f32x16& p0, f32x16& p1, float& m_reg, float& mn, float& alpha) {
  constexpr float C = SCALE * 1.4426950408889634f;
  float pmax = p0[0]; for (int r = 1; r < 16; ++r) pmax = fmaxf(pmax, p0[r]); for (int r = 0; r < 16; ++r) pmax = fmaxf(pmax, p1[r]);
  { auto rr = __builtin_amdgcn_permlane32_swap(__float_as_uint(pmax), __float_as_uint(pmax), false, false);
    pmax = fmaxf(__uint_as_float(rr[0]), __uint_as_float(rr[1])); }
  if (__builtin_expect(__all(pmax - m_reg <= THR / SCALE), 1)) { mn = m_reg; alpha = 1.f; }
  else { mn = fmaxf(m_reg, pmax); alpha = __builtin_amdgcn_exp2f((m_reg - mn) * C); m_reg = mn; }
  float mnC = -mn * C;
  for (int r = 0; r < 16; ++r) p0[r] = fmaf(p0[r], C, mnC); for (int r = 0; r < 16; ++r) p1[r] = fmaf(p1[r], C, mnC);
  for (int r = 0; r < 16; ++r) p0[r] = __builtin_amdgcn_exp2f(p0[r]);
}
__device__ __forceinline__ void finishSM(f32x16& p0, f32x16& p1, float alpha, float& l_reg, bf16x8& pa0, bf16x8& pa1, bf16x8& pa2, bf16x8& pa3) {
  for (int r = 0; r < 16; ++r) p1[r] = __builtin_amdgcn_exp2f(p1[r]);
  float ps = 0; for (int r = 0; r < 16; ++r) ps += p0[r]; for (int r = 0; r < 16; ++r) ps += p1[r];
  { auto rr = __builtin_amdgcn_permlane32_swap(__float_as_uint(ps), __float_as_uint(ps), false, false);
    ps = __uint_as_float(rr[0]) + __uint_as_float(rr[1]); }
  l_reg = l_reg * alpha + ps;
#define PK4(P, BASE, OUT) do { unsigned a0 = cvtpk(P[BASE + 0], P[BASE + 1]), a1 = cvtpk(P[BASE + 2], P[BASE + 3]);   \
    unsigned b0 = cvtpk(P[BASE + 4], P[BASE + 5]), b1 = cvtpk(P[BASE + 6], P[BASE + 7]);                              \
    auto r0 = __builtin_amdgcn_permlane32_swap(a0, b0, false, false); auto r1 = __builtin_amdgcn_permlane32_swap(a1, b1, false, false); \
    u32x4 w = {r0[0], r1[0], r0[1], r1[1]}; OUT = *reinterpret_cast<bf16x8*>(&w); } while (0)
  PK4(p0, 0, pa0); PK4(p0, 8, pa1); PK4(p1, 0, pa2); PK4(p1, 8, pa3);
#undef PK4
}
__device__ __forceinline__ void qkt(f32x16& p0, f32x16& p1, const bf16* Ks, const bf16x8* qr, int r32, int hi) {
  p0 = f32x16{}; p1 = f32x16{};
  for (int d0 = 0; d0 < 8; ++d0) { int cb = (d0 * 16 + hi * 8) * 2;
    bf16x8 b0 = *reinterpret_cast<const bf16x8*>((const char*)Ks + KSWZ(r32, cb));
    bf16x8 b1 = *reinterpret_cast<const bf16x8*>((const char*)Ks + KSWZ(32 + r32, cb));
    p0 = __builtin_amdgcn_mfma_f32_32x32x16_bf16(b0, qr[d0], p0, 0, 0, 0);
    p1 = __builtin_amdgcn_mfma_f32_32x32x16_bf16(b1, qr[d0], p1, 0, 0, 0); }
}
__device__ __forceinline__ int v_st(int k, int c) { const int kk = (k & ~0xC) | ((k & 4) << 1) | ((k & 8) >> 1); return ((kk >> 3) * 4 + (c >> 5)) * 512 + ((kk & 7) * 32 + (c & 31)) * 2; }
__device__ __forceinline__ int v_rd_base(int lane) { return ((lane & 3) << 3) | (((lane >> 2) & 3) << 6) | (((lane >> 4) & 1) << 5) | (((lane >> 5) & 1) << 8); }
constexpr int v_rd_off(int d0, int ks, int half) { return d0 * 512 + ks * 4096 + half * 2048; }
template <int OFF> __device__ __forceinline__ s16x4 tr_read(int vb) {
  s16x4 r; asm volatile("ds_read_b64_tr_b16 %0, %1 offset:%2" : "=&v"(r) : "v"(vb), "i"(OFF) : "memory"); return r;
}
template <int D0> __device__ __forceinline__ void pv_one(f32x16& od, int vb, bf16x8 pa0, bf16x8 pa1, bf16x8 pa2, bf16x8 pa3) {
  const s16x4 l0 = tr_read<v_rd_off(D0, 0, 0)>(vb), h0 = tr_read<v_rd_off(D0, 0, 1)>(vb), l1 = tr_read<v_rd_off(D0, 1, 0)>(vb), h1 = tr_read<v_rd_off(D0, 1, 1)>(vb);
  const s16x4 l2 = tr_read<v_rd_off(D0, 2, 0)>(vb), h2 = tr_read<v_rd_off(D0, 2, 1)>(vb), l3 = tr_read<v_rd_off(D0, 3, 0)>(vb), h3 = tr_read<v_rd_off(D0, 3, 1)>(vb);
  asm volatile("s_waitcnt lgkmcnt(0)" ::: "memory"); SBAR();
#define PK(L, H) (bf16x8){L[0], L[1], L[2], L[3], H[0], H[1], H[2], H[3]}
  od = __builtin_amdgcn_mfma_f32_32x32x16_bf16(pa0, PK(l0, h0), od, 0, 0, 0);
  od = __builtin_amdgcn_mfma_f32_32x32x16_bf16(pa1, PK(l1, h1), od, 0, 0, 0);
  od = __builtin_amdgcn_mfma_f32_32x32x16_bf16(pa2, PK(l2, h2), od, 0, 0, 0);
  od = __builtin_amdgcn_mfma_f32_32x32x16_bf16(pa3, PK(l3, h3), od, 0, 0, 0);
#undef PK
}
__device__ __forceinline__ void pv_d0(f32x16* o, int vb, bf16x8 pa0, bf16x8 pa1, bf16x8 pa2, bf16x8 pa3) {
  pv_one<0>(o[0], vb, pa0, pa1, pa2, pa3); pv_one<1>(o[1], vb, pa0, pa1, pa2, pa3); pv_one<2>(o[2], vb, pa0, pa1, pa2, pa3); pv_one<3>(o[3], vb, pa0, pa1, pa2, pa3);
}

template <typename TQ>
__device__ __forceinline__ void attn_dense_body(const TQ* __restrict__ Qb, const bf16* __restrict__ Kh, const bf16* __restrict__ Vh,
                                                unsigned short* __restrict__ Ob, int seq, char* lds, const int tid_in) {
  using St = Stage<bf16>; using SQ = Stage<TQ>;
  const int tid = tid_in  , wid = tid >> 6, lane = tid & 63, r32 = lane & 31, hi = lane >> 5;
  bf16* V_lds = (bf16*)lds; bf16* K_lds = (bf16*)(lds + 2 * SHM_V);
  float* ws = (float*)(lds + 2 * SHM_V + 2 * SHM_K) + wid * 64; float* li_l = ws; float* al_l = ws + 32;
  float m_reg = -1e30f, l_reg = 0; f32x16 o[4] = {}; bf16x8 qr[8];
  const TQ* Qw = Qb + (long)(wid * QBLK + r32) * LDQ + hi * 8;
#pragma unroll
  for (int d0 = 0; d0 < 8; ++d0) qr[d0] = SQ::tobf(SQ::ld8(Qw + d0 * 16));
  const int sr = tid >> 4, sc = (tid & 15) * 8, vst0 = v_st(sr, sc), vst1 = v_st(32 + sr, sc);
  const int vb0 = (int)(uintptr_t)V_lds + v_rd_base(lane);
  struct { typename St::T vs0, vs1, ks0, ks1; } sr_[SDEPTH];
#define SLOAD(i, k0) do { sr_[i].vs0 = St::ld8(&Vh[(long)((k0) + sr) * LDV + sc]); sr_[i].vs1 = St::ld8(&Vh[(long)((k0) + 32 + sr) * LDV + sc]); \
    sr_[i].ks0 = St::ld8(&Kh[(long)((k0) + sr) * LDK + sc]); sr_[i].ks1 = St::ld8(&Kh[(long)((k0) + 32 + sr) * LDK + sc]); } while (0)
#define SWRITE(b, i) do { *(bf16x8*)((char*)V_lds + (b) * SHM_V + vst0) = St::tobf(sr_[i].vs0);          \
    *(bf16x8*)((char*)V_lds + (b) * SHM_V + vst1) = St::tobf(sr_[i].vs1); int kc = sc * 2;               \
    *(bf16x8*)((char*)K_lds + (b) * SHM_K + KSWZ(sr, kc)) = St::tobf(sr_[i].ks0);                       \
    *(bf16x8*)((char*)K_lds + (b) * SHM_K + KSWZ(32 + sr, kc)) = St::tobf(sr_[i].ks1); } while (0)
#define SWAIT() do { if constexpr (SDEPTH == 2) asm volatile("s_waitcnt vmcnt(4)" ::: "memory"); else asm volatile("s_waitcnt vmcnt(0)" ::: "memory"); } while (0)
#define RESC(a) do { if (__any((a) < 1.f)) { if (hi == 0) al_l[r32] = (a); asm volatile("s_waitcnt lgkmcnt(0)" ::: "memory"); \
    for (int d = 0; d < 4; ++d) for (int r = 0; r < 16; ++r) o[d][r] *= al_l[crow(r, hi)]; } } while (0)
  f32x16 pA0, pA1, pB0, pB1; float mnA, mnB, alA, alB; bf16x8 pa0, pa1, pa2, pa3; const int NT = seq / KVBLK;
  constexpr int SE = 0, SO = SDEPTH - 1;
  SLOAD(SE, 0); asm volatile("s_waitcnt vmcnt(0)" ::: "memory"); SWRITE(0, SE); __syncthreads();
  qkt(pA0, pA1, K_lds, qr, r32, hi); partialSM(pA0, pA1, m_reg, mnA, alA);
  SLOAD(SO, KVBLK); if constexpr (SDEPTH == 2) { if (2 < NT) SLOAD(SE, 2 * KVBLK); }
  SWAIT(); SWRITE(1, SO); __syncthreads();
  for (int j = 1; j + 1 < NT; j += 2) {
    SBAR(); qkt(pB0, pB1, (bf16*)((char*)K_lds + SHM_K), qr, r32, hi);
    finishSM(pA0, pA1, alA, l_reg, pa0, pa1, pa2, pa3); SBAR();
    SLOAD(SO, (j + SDEPTH) * KVBLK); SBAR();
    pv_d0(o, vb0, pa0, pa1, pa2, pa3); partialSM(pB0, pB1, m_reg, mnB, alB);
    __syncthreads(); SWAIT(); SWRITE(0, SE);
    RESC(alB); __syncthreads();
    SBAR(); qkt(pA0, pA1, K_lds, qr, r32, hi);
    finishSM(pB0, pB1, alB, l_reg, pa0, pa1, pa2, pa3); SBAR();
    if (SDEPTH == 1 || j + 3 < NT) SLOAD(SE, (j + 1 + SDEPTH) * KVBLK); SBAR();
    pv_d0(o, vb0 + (int)SHM_V, pa0, pa1, pa2, pa3); partialSM(pA0, pA1, m_reg, mnA, alA);
    __syncthreads(); SWAIT(); SWRITE(1, SO);
    RESC(alA); __syncthreads();
  }
  SBAR(); qkt(pB0, pB1, (bf16*)((char*)K_lds + SHM_K), qr, r32, hi);
  finishSM(pA0, pA1, alA, l_reg, pa0, pa1, pa2, pa3); SBAR();
  pv_d0(o, vb0, pa0, pa1, pa2, pa3); partialSM(pB0, pB1, m_reg, mnB, alB);
  __syncthreads(); RESC(alB);
  finishSM(pB0, pB1, alB, l_reg, pa0, pa1, pa2, pa3); SBAR();
  pv_d0(o, vb0 + (int)SHM_V, pa0, pa1, pa2, pa3);
  if (hi == 0) li_l[r32] = l_reg; asm volatile("s_waitcnt lgkmcnt(0)" ::: "memory");
  float rli[16];
#pragma unroll
  for (int r = 0; r < 16; ++r) rli[r] = __builtin_amdgcn_rcpf(li_l[crow(r, hi)]);
  unsigned short* Ow = Ob + (long)(wid * QBLK) * LDO;
#pragma unroll
  for (int r = 0; r < 16; ++r) { int orow = crow(r, hi);
    for (int d0 = 0; d0 < 4; ++d0) Ow[(long)orow * LDO + d0 * 32 + r32] = (unsigned short)f2bf(o[d0][r] * rli[r]); }
  __syncthreads();
#undef SLOAD
#undef SWRITE
#undef SWAIT
#undef RESC
}
#undef KSWZ
#undef SBAR
}

#define XB_TMO      128
#define XB_XCNT(j)  (256  + 64 * (j))
#define XB_XSUB(j)  (1280 + 64 * (j))
#define XB_XGEN(j)  (2304 + 64 * (j))
#define XB_TOP      3328
#define XB_TOPGEN   3392
#define XCD_BAR_WORDS 3456
#define XB_SPIN_CAP (1u << 18)

__device__ __forceinline__ unsigned xb_ld(unsigned* p)              { return __hip_atomic_load(p, __ATOMIC_RELAXED, __HIP_MEMORY_SCOPE_AGENT); }
__device__ __forceinline__ unsigned xb_add(unsigned* p, unsigned v) { return __hip_atomic_fetch_add(p, v, __ATOMIC_RELAXED, __HIP_MEMORY_SCOPE_AGENT); }
__device__ __forceinline__ unsigned xb_xcc_id() { return (unsigned)__builtin_amdgcn_s_getreg((3 << 11) | 20) & 0xFu; }
#define XB_SPIN(cond, bar) do { unsigned _sp = 0; while (cond) { __builtin_amdgcn_s_sleep(1); \
    if ((++_sp & 255u) == 0u) { if (xb_ld(&(bar)[XB_TMO])) break; if (_sp > XB_SPIN_CAP) { atomicAdd(&(bar)[XB_TMO], 1u); break; } } } } while (0)

struct XcdBarrier {
    unsigned* bar; unsigned x;
    volatile LAS unsigned* st;
};

__device__ __forceinline__ XcdBarrier xcd_barrier_post(unsigned* bar, volatile LAS unsigned* st) {
    XcdBarrier b; b.bar = bar; b.x = xb_xcc_id(); b.st = st;
    if (threadIdx.x == 0) (void)xb_add(&bar[XB_XCNT(b.x)], 1u);
    return b;
}
__device__ __forceinline__ void xcd_barrier_complete(unsigned* bar, unsigned x, unsigned& nloc, unsigned& nx) {
    const unsigned G = gridDim.x * gridDim.y * gridDim.z;
    unsigned sum, cnt, mine, sp = 0u;
    for (;;) {
        sum = 0u; cnt = 0u; mine = 0u;
#pragma unroll
        for (unsigned j = 0; j < 16; ++j) { const unsigned c = xb_ld(&bar[XB_XCNT(j)]); sum += c; cnt += (c > 0u) ? 1u : 0u; mine = (j == x) ? c : mine; }
        if (sum == G) break;
        __builtin_amdgcn_s_sleep(1);
        if ((++sp & 255u) == 0u) { if (xb_ld(&bar[XB_TMO])) break; if (sp > XB_SPIN_CAP) { atomicAdd(&bar[XB_TMO], 1u); break; } }
    }
    nloc = mine > 0u ? mine : 1u; nx = cnt > 0u ? cnt : 1u;
}

__device__ __forceinline__ void xcd_barrier(const XcdBarrier& b) {
    asm volatile("s_waitcnt vmcnt(0)" ::: "memory");
    __syncthreads();
    if (threadIdx.x == 0) {
        unsigned* bar = b.bar;
        __builtin_amdgcn_s_waitcnt(0);
        unsigned nloc = b.st[0], nx = b.st[1];
        if (nloc == 0u) { xcd_barrier_complete(bar, b.x, nloc, nx); b.st[0] = nloc; b.st[1] = nx; }
        const unsigned old = xb_add(&bar[XB_XSUB(b.x)], 1u);
        const unsigned gen = old / nloc;
        if (old + 1u == (gen + 1u) * nloc) {
            __builtin_amdgcn_fence(__ATOMIC_RELEASE, "agent");
            asm volatile("s_waitcnt vmcnt(0)" ::: "memory");
            const unsigned og = xb_add(&bar[XB_TOP], 1u);
            const unsigned tg = og / nx;
            if (og + 1u == (tg + 1u) * nx) xb_add(&bar[XB_TOPGEN], 1u);
            else XB_SPIN(xb_ld(&bar[XB_TOPGEN]) == tg, bar);
            __builtin_amdgcn_fence(__ATOMIC_ACQUIRE, "agent");
            xb_add(&bar[XB_XGEN(b.x)], 1u);
            asm volatile("s_waitcnt vmcnt(0)" ::: "memory");
        } else {
            XB_SPIN(xb_ld(&bar[XB_XGEN(b.x)]) == gen, bar);
            __builtin_amdgcn_fence(__ATOMIC_ACQUIRE, "agent");
            asm volatile("s_waitcnt vmcnt(0)" ::: "memory");
        }
    }
    __syncthreads();
}
struct Ctx {
    LAS unsigned char* lds;
    volatile LAS unsigned* MISC;
    gu32* ctl;
    int tid, lane, wave, G, bid;
    float* out; unsigned char* ws;
};
__device__ __forceinline__ const float* inp(const Ctx& F, int i) { const unsigned long long v = *(volatile LAS unsigned long long*)(F.lds + INTAB_OFF + 8 * i);
    const unsigned lo = __builtin_amdgcn_readfirstlane((unsigned)v), hi = __builtin_amdgcn_readfirstlane((unsigned)(v >> 32)); return (const float*)(const GAS float*)(((unsigned long long)hi << 32) | lo); }
#define WSP(T, off) ((T*)(F.ws + (off)))
__device__ __forceinline__ void sincos_rev(float ang, float& s, float& c) {
    float t = ang * 0.15915494309189535f; t -= rintf(t); s = __builtin_amdgcn_sinf(t); c = __builtin_amdgcn_cosf(t); }

__device__ __forceinline__ void transpose_item(const float* W, int Nsrc, int nsrc0  , int k0, bf16* WT, int K, int ndst0, LAS float* scr, int lane, int kd = 0  ) {
    const int c = lane & 7;
    if (nsrc0 < 0) {
#pragma unroll
        for (int j = 0; j < 4; ++j) { const int n = (lane >> 3) + 8 * j; *(GAS v4u*)(WT + (size_t)(ndst0 + n) * K + kd + k0 + 8 * c) = (v4u){0u, 0u, 0u, 0u}; }
        return;
    }
    float wv[32];
#pragma unroll
    for (int i = 0; i < 32; ++i) wv[i] = *(const GAS float*)(W + (size_t)(k0 + 2 * i + (lane >> 5)) * Nsrc + nsrc0 + (lane & 31));
#pragma unroll
    for (int i = 0; i < 32; ++i) scr[(2 * i + (lane >> 5)) * 33 + (lane & 31)] = wv[i];
    LDS_WAIT(); asm volatile("" ::: "memory");
#pragma unroll
    for (int j = 0; j < 4; ++j) { const int n = (lane >> 3) + 8 * j; const LAS float* s = scr + (8 * c) * 33 + n;
        v4u o; o.x = pk2(s[0 * 33], s[1 * 33]); o.y = pk2(s[2 * 33], s[3 * 33]); o.z = pk2(s[4 * 33], s[5 * 33]); o.w = pk2(s[6 * 33], s[7 * 33]);
        *(GAS v4u*)(WT + (size_t)(ndst0 + n) * K + kd + k0 + 8 * c) = o; }
    LDS_WAIT(); asm volatile("" ::: "memory");
}
constexpr int TI_IN = 64 * (NP / 32), TI_GLU = 16 * 32, TI_PS = 16 * 128, TI_PA = 32 * 128, TI_O = 64 * 128;
constexpr int TI_PER_L = TI_IN + TI_GLU + 2 * TI_PS + TI_PA + TI_O;
constexpr int TJ_ITEMS = 32, TJ_JOBS = TI_PER_L / TJ_ITEMS;
__device__ __forceinline__ void transpose_one(Ctx& F, int l, int r, LAS float* scr) {
    if (r < TI_IN) { const int nblk = NP / 32, kb = r / nblk, nb = r % nblk, nd = nb * 32;
        const int ns = nd < 5120 ? nd : (nd < 22528 ? nd + 32 : (nd < 22560 ? nd - 22528 + 5120 : -1));
        transpose_item(inp(F, I_WIN) + (size_t)l * DM * NIN, NIN, ns, kb * 64, WSP(bf16, WS_WIN) + (size_t)l * NP * DM, DM, nd, scr, F.lane); return; }
    r -= TI_IN;
    if (r < TI_GLU) { const int kb = r / 32, nb = r % 32; transpose_item(inp(F, I_WGLU) + (size_t)l * 1024 * 1024, 1024, nb * 32, kb * 64, WSP(bf16, WS_WGLU) + (size_t)l * 1024 * 1024, 1024, nb * 32, scr, F.lane); return; }
    r -= TI_GLU;
    if (r < TI_PS) { const int kb = r / 128, nb = r % 128; transpose_item(inp(F, I_WPS) + (size_t)l * 1024 * DM, DM, nb * 32, kb * 64, WSP(bf16, WS_WCAT) + (size_t)l * DM * DM, DM, nb * 32, scr, F.lane, 0); return; }
    r -= TI_PS;
    if (r < TI_PS) { const int kb = r / 128, nb = r % 128; transpose_item(inp(F, I_WPG) + (size_t)l * 1024 * DM, DM, nb * 32, kb * 64, WSP(bf16, WS_WCAT) + (size_t)l * DM * DM, DM, nb * 32, scr, F.lane, 1024); return; }
    r -= TI_PS;
    if (r < TI_PA) { const int kb = r / 128, nb = r % 128; transpose_item(inp(F, I_WPA) + (size_t)l * 2048 * DM, DM, nb * 32, kb * 64, WSP(bf16, WS_WCAT) + (size_t)l * DM * DM, DM, nb * 32, scr, F.lane, 2048); return; }
    r -= TI_PA;
    { const int kb = r / 128, nb = r % 128; transpose_item(inp(F, I_WOUT) + (size_t)l * DM * DM, DM, nb * 32, kb * 64, WSP(bf16, WS_WO) + (size_t)l * DM * DM, DM, nb * 32, scr, F.lane); }
}
__device__ __forceinline__ void ph_transposes(Ctx& F) {
    LAS float* scr = (LAS float*)(F.lds + RING_OFF + F.wave * 16384);
    const int gw = F.bid * NWAVES + F.wave, NGW = F.G * NWAVES;
    for (int r = gw; r < TI_PER_L; r += NGW) transpose_one(F, 0, r, scr);
}
__device__ __forceinline__ void transpose_job(Ctx& F, int layer, int j) {
    LAS float* scr = (LAS float*)(F.lds + RING_OFF + F.wave * 16384);
#pragma unroll 1
    for (int i = 0; i < TJ_ITEMS / NWAVES; ++i) transpose_one(F, layer, j * TJ_ITEMS + i * NWAVES + F.wave, scr);
}
__device__ __forceinline__ void transposes_fill(Ctx& F, unsigned* cnt, int jlo, int jhi) {
    LAS float* scr = (LAS float*)(F.lds + RING_OFF + F.wave * 16384);
    for (;;) {
        __syncthreads();
        if (F.tid == 0) F.MISC[17] = __hip_atomic_fetch_add(cnt, 1u, RLX_AGENT);
        __syncthreads();
        const int j = jlo + (int)F.MISC[17];
        if (j >= jhi) break;
#pragma unroll 1
        for (int i = 0; i < TJ_ITEMS / NWAVES; ++i) transpose_one(F, 1, j * TJ_ITEMS + i * NWAVES + F.wave, scr);
    }
}
__device__ __forceinline__ void mod_partial_item(Ctx& F, int item) {
    LAS float* sc = (LAS float*)(F.lds + RING_OFF);
    {
        const int l = item / 192, rem = item % 192, nblk = rem / 32, ks = rem % 32;
        __syncthreads();
        if (F.tid < 384) { const int rr = F.tid / 128, kk = F.tid % 128; const float v = rr < 2 ? inp(F, I_C)[rr * DM + ks * 128 + kk] : inp(F, I_CCTX)[ks * 128 + kk]; sc[F.tid] = siluf_(v); }
        __syncthreads();
        const int n = nblk * 2048 + F.tid * 4;
        const float* w = inp(F, I_WMOD) + ((size_t)l * DM + (size_t)ks * 128) * 12288 + n;
        f32x4 a0 = {0.f, 0.f, 0.f, 0.f}, a1 = a0, a2 = a0;
#pragma unroll 8
        for (int kk = 0; kk < 128; ++kk) { const f32x4 wv = *(const GAS f32x4*)(w + (size_t)kk * 12288); a0 += sc[kk] * wv; a1 += sc[128 + kk] * wv; a2 += sc[256 + kk] * wv; }
        float* o = WSP(float, WS_MODP) + ((size_t)(l * 32 + ks) * 3) * 12288 + n;
        *(f32x4*)o = a0; *(f32x4*)(o + 12288) = a1; *(f32x4*)(o + 2 * 12288) = a2;
    }
    __syncthreads();
}
__device__ __forceinline__ void ph_mod_reduce(Ctx& F) {
    const float* mp = WSP(float, WS_MODP); float* mo = WSP(float, WS_MOD);
    for (int e = F.bid * NTHR + F.tid; e < 2 * 3 * 12288; e += F.G * NTHR) {
        const int l = e / 36864, rem = e % 36864, r = rem / 12288, n = rem % 12288;
        float s = inp(F, I_BMOD)[l * 12288 + n];
        for (int ks = 0; ks < 32; ++ks) s += mp[((size_t)(l * 32 + ks) * 3 + r) * 12288 + n];
        mo[e] = s;
    }
}
__device__ __forceinline__ void ph_rope_table(Ctx& F) {
    float* tb = WSP(float, WS_ROPE);
    for (int e = F.bid * NTHR + F.tid; e < 2048; e += F.G * NTHR) {
        const int pos = e >> 5, f = e & 31;
        const float inv = exp2f(-(float)f * (13.287712379549449f / 32.0f));
        float s, c; sincos_rev((float)pos * inv, s, c);
        tb[e] = c; tb[2048 + e] = s;
    }
}
__device__ __forceinline__ void s5_mats_item(Ctx& F, int item) {
    LAS float* L = (LAS float*)(F.lds + RING_OFF);
    LAS float* zr = L; LAS float* zi = L + 64; LAS float* qr = L + 128; LAS float* qi = L + 192;
    LAS float* bbr = L + 256; LAS float* bbi = bbr + 1024;
    LAS float* cmr = bbi + 1024; LAS float* cmi = cmr + 1024;
    LAS float* pdr = cmi + 1024; LAS float* pdi = pdr + 1024;
    {
        const int ld = item >> 6, g = item & 63;
        bf16* TG = WSP(bf16, WS_TG) + (size_t)item * 256 * 384;
        bf16* WT = WSP(bf16, WS_WT) + (size_t)item * 128 * 256;
        float* L16 = WSP(float, WS_L16) + (size_t)item * 128;
        __syncthreads();
        if (F.tid < 64) { const int n = F.tid; const size_t pi = ((size_t)ld * 64 + g) * 64 + n;
            const float lr = fminf(inp(F, I_LAMRE)[pi], -1e-4f), li = inp(F, I_LAMIM)[pi], dt = __expf(inp(F, I_LOGDT)[ld * 64 + g]);
            const float a = lr * dt, b = li * dt; zr[n] = a; zi[n] = b;
            float sb, cb, sh, ch; sincos_rev(b, sb, cb); sincos_rev(0.5f * b, sh, ch);
            const float em1 = expm1f(a), ea = em1 + 1.0f;
            const float nr = em1 * cb - 2.0f * sh * sh, ni = ea * sb;
            const float den = 1.0f / (lr * lr + li * li);
            qr[n] = (nr * lr + ni * li) * den; qi[n] = (ni * lr - nr * li) * den;
            float s16, c16; sincos_rev(16.0f * b, s16, c16); const float m16 = __expf(16.0f * a);
            L16[2 * n] = m16 * c16; L16[2 * n + 1] = m16 * s16; }
        __syncthreads();
        for (int e = F.tid; e < 1024; e += NTHR) {
            { const int n = e >> 4; const size_t bi = (((size_t)ld * 64 + g) * 64) * 16 + e; const float br = inp(F, I_BRE)[bi], bim = inp(F, I_BIM)[bi];
              bbr[e] = qr[n] * br - qi[n] * bim; bbi[e] = qr[n] * bim + qi[n] * br; }
            { const size_t ci = (((size_t)ld * 64 + g) * 16) * 64 + e; cmr[e] = inp(F, I_CRE)[ci]; cmi[e] = inp(F, I_CIM)[ci]; }
        }
        __syncthreads();
        for (int d = 0; d <= 16; ++d) {
            for (int e = F.tid; e < 1024; e += NTHR) {
                { const int n = e & 63; float s, c; sincos_rev((float)d * zi[n], s, c); const float mg = __expf((float)d * zr[n]); const float er = mg * c, ei = mg * s;
                  pdr[e] = cmr[e] * er - cmi[e] * ei; pdi[e] = cmr[e] * ei + cmi[e] * er; }
                if (d <= 15) { const int n = e >> 4, p = e & 15; float s, c; sincos_rev((float)d * zi[n], s, c); const float mg = __expf((float)d * zr[n]); const float er = mg * c, ei = mg * s;
                  const float vr = er * bbr[e] - ei * bbi[e], vi = er * bbi[e] + ei * bbr[e];
                  WT[(size_t)(2 * n) * 256 + (15 - d) * 16 + p] = (bf16)f2bf(vr); WT[(size_t)(2 * n + 1) * 256 + (15 - d) * 16 + p] = (bf16)f2bf(vi); }
            }
            __syncthreads();
            if (d <= 15 && F.tid < 256) { const int pp = F.tid >> 4, p = F.tid & 15; float s = 0.f;
                for (int n = 0; n < 64; ++n) s += pdr[pp * 64 + n] * bbr[n * 16 + p] - pdi[pp * 64 + n] * bbi[n * 16 + p];
                const bf16 v = (bf16)f2bf(s);
                for (int i = d; i < 16; ++i) TG[(size_t)(i * 16 + pp) * 384 + (i - d) * 16 + p] = v; }
            if (d >= 1) for (int e = F.tid; e < 1024; e += NTHR) { const int pp = e >> 6, n = e & 63;
                TG[(size_t)((d - 1) * 16 + pp) * 384 + 256 + 2 * n] = (bf16)f2bf(pdr[e]); TG[(size_t)((d - 1) * 16 + pp) * 384 + 256 + 2 * n + 1] = (bf16)f2bf(-pdi[e]); }
            __syncthreads();
        }
        for (int e = F.tid; e < 256 * 256; e += NTHR) { const int row = e >> 8, col = e & 255; if ((col >> 4) > (row >> 4)) TG[(size_t)row * 384 + col] = 0; }
    }
    __syncthreads();
}
__device__ __forceinline__ void ph_norm(Ctx& F, int layer, bool ctxsplit) {
    const int gw = F.bid * NWAVES + F.wave, NGW = F.G * NWAVES;
    const float* ng = inp(F, I_NORMG) + layer * DM; const float* MODl = WSP(float, WS_MOD) + (size_t)layer * 3 * 12288;
    for (int r = gw; r < MROWS; r += NGW) {
        const int b = r / RPB, j = r % RPB; const bool isctx = j < TC;
        const bool fold = (layer == 1 && isctx && ctxsplit);
        const float* src = (layer == 0 || fold) ? (isctx ? inp(F, I_CTX) + ((size_t)b * TC + j) * DM : inp(F, I_X) + ((size_t)b * TL + (j - TC)) * DM) : WSP(float, WS_X1) + (size_t)r * DM;
        const float* md = MODl + (size_t)(isctx ? 2 : b) * 12288;
        const GAS f32x4* xr = (const GAS f32x4*)src + F.lane;
        f32x4 v[16]; float s = 0.f;
#pragma unroll
        for (int q = 0; q < 16; ++q) v[q] = xr[64 * q];
        if (fold) { const float* g0v = WSP(float, WS_MOD) + (size_t)2 * 12288 + 8192 + 4 * F.lane; const float* pt = WSP(float, WS_PART) + ((size_t)b * 256 + j) * DM + 4 * F.lane;
#pragma unroll 1
            for (int ks = 0; ks < 8; ++ks) {
#pragma unroll
                for (int q = 0; q < 16; ++q) v[q] += *(const GAS f32x4*)(g0v + 256 * q) * *(const GAS f32x4*)(pt + 256 * q);
                pt += (size_t)512 * DM; } }
#pragma unroll
        for (int q = 0; q < 16; ++q) s += (v[q].x * v[q].x + v[q].y * v[q].y) + (v[q].z * v[q].z + v[q].w * v[q].w);
        const float rstd = 1.0f / sqrtf(wave_sum(s) * (1.0f / DM) + EPS);
        GAS v2u* o8 = (GAS v2u*)(WSP(bf16, WS_H) + (size_t)r * DM) + F.lane;
#pragma unroll
        for (int q = 0; q < 16; ++q) { const int d0 = 256 * q + 4 * F.lane;
            const f32x4 g4 = *(const GAS f32x4*)(ng + d0), sh = *(const GAS f32x4*)(md + d0), sc = *(const GAS f32x4*)(md + 4096 + d0);
            const f32x4 y = v[q] * rstd * g4 * (sc + 1.0f) + sh;
            o8[64 * q] = (v2u){pk2(y.x, y.y), pk2(y.z, y.w)}; }
    }
}
__device__ __forceinline__ void ph_final(Ctx& F) {
    const int gw = F.bid * NWAVES + F.wave, NGW = F.G * NWAVES; const float* fg = inp(F, I_FINALG);
    for (int r = gw; r < NB * TL; r += NGW) {
        GAS f32x4* xr = (GAS f32x4*)(F.out + (size_t)r * DM) + F.lane;
        f32x4 v[16]; float s = 0.f;
#pragma unroll
        for (int q = 0; q < 16; ++q) { v[q] = xr[64 * q]; s += (v[q].x * v[q].x + v[q].y * v[q].y) + (v[q].z * v[q].z + v[q].w * v[q].w); }
        const float rstd = 1.0f / sqrtf(wave_sum(s) * (1.0f / DM) + EPS);
#pragma unroll
        for (int q = 0; q < 16; ++q) { const f32x4 g4 = *(const GAS f32x4*)(fg + 256 * q + 4 * F.lane); xr[64 * q] = v[q] * rstd * g4; }
    }
}
__device__ __forceinline__ void attn_prep_rows(Ctx& F, int layer, int r_lo, int r_hi) {
    const bf16* P = WSP(bf16, WS_P); const float* tb = WSP(float, WS_ROPE);
    const float* gq = inp(F, I_AQG) + layer * 128; const float* gk = inp(F, I_AKG) + layer * 128;
    const int lane = F.lane, hq = lane >> 4, li = lane & 15, d0 = 8 * li;
    const f32x4 gqa = *(const GAS f32x4*)(gq + d0), gqb = *(const GAS f32x4*)(gq + d0 + 4), gka = *(const GAS f32x4*)(gk + d0), gkb = *(const GAS f32x4*)(gk + d0 + 4);
    const float sg = (li & 4) ? 1.0f : -1.0f; const int f0 = 8 * (li & 3);
    for (int it = r_lo * 6 + F.wave; it < r_hi * 6; it += NWAVES) {
        const int r = it / 6, grp = it % 6; const int j = r % RPB; const bool isctx = j < TC;
        if (layer == 1 && isctx && grp < 4) continue;
        const int scol = grp < 4 ? C_AQ + grp * 512 : (grp == 4 ? C_AK : C_AV);
        const v4u w = *(const GAS v4u*)(P + (size_t)r * NP + scol + hq * 128 + d0);
        if (grp == 5) { *(GAS v4u*)(WSP(bf16, WS_VN) + (size_t)r * 512 + hq * 128 + d0) = w; continue; }
        f32x4 xa = (f32x4){bflo(w.x), bfhi(w.x), bflo(w.y), bfhi(w.y)}, xb = (f32x4){bflo(w.z), bfhi(w.z), bflo(w.w), bfhi(w.w)};
        float ss = (xa.x * xa.x + xa.y * xa.y) + (xa.z * xa.z + xa.w * xa.w) + (xb.x * xb.x + xb.y * xb.y) + (xb.z * xb.z + xb.w * xb.w);
        ss += __shfl_xor(ss, 1); ss += __shfl_xor(ss, 2); ss += __shfl_xor(ss, 4); ss += __shfl_xor(ss, 8);
        const float rstd = 1.0f / sqrtf(ss * (1.0f / 128.0f) + EPS);
        xa = xa * rstd * (grp < 4 ? gqa : gka); xb = xb * rstd * (grp < 4 ? gqb : gkb);
        if (!isctx) {
            const int t = j - TC; const int pos = (li >> 3) ? (t & 63) : (t >> 6);
            const f32x4 ca = *(const GAS f32x4*)(tb + pos * 32 + f0), cb = *(const GAS f32x4*)(tb + pos * 32 + f0 + 4), sa = *(const GAS f32x4*)(tb + 2048 + pos * 32 + f0), sb = *(const GAS f32x4*)(tb + 2048 + pos * 32 + f0 + 4);
            f32x4 pa, pb;
#pragma unroll
            for (int e = 0; e < 4; ++e) { pa[e] = __shfl_xor(xa[e], 4); pb[e] = __shfl_xor(xb[e], 4); }
            xa = xa * ca + sg * pa * sa; xb = xb * cb + sg * pb * sb;
        }
        const v4u o = (v4u){pk2(xa.x, xa.y), pk2(xa.z, xa.w), pk2(xb.x, xb.y), pk2(xb.z, xb.w)};
        bf16* dst = grp < 4 ? WSP(bf16, WS_QN) + (size_t)r * 2048 + (grp * 4 + hq) * 128 + d0 : WSP(bf16, WS_KN) + (size_t)r * 512 + hq * 128 + d0;
        *(GAS v4u*)dst = o;
    }
}
__device__ __forceinline__ float log_sigmoid_(float z) { return fminf(z, 0.f) - __logf(1.0f + __expf(-fabsf(z))); }
__device__ __forceinline__ void gla_prep_item(Ctx& F, int layer, int it) {
    const bf16* P = WSP(bf16, WS_P);
    LAS float* lrs = (LAS float*)(F.lds + RING_OFF);
    LAS unsigned char* tq = F.lds + RING_OFF + 4096 + F.wave * 17408;
    LAS unsigned char* tk = tq + 4608;
    LAS float* bbs = (LAS float*)(tq + 9216) + F.lane;
    const int lane = F.lane, h = F.wave, col = h * 64 + lane, fr = lane & 15, fq = lane >> 4;
    {
        const int b = it / GNCH, c = it % GNCH; const size_t r0 = (size_t)b * RPB + (size_t)c * GCH;
        __syncthreads();
        { const int tok = F.tid >> 4, cc = (F.tid & 15) * 2; const unsigned w = *(const GAS unsigned*)(P + (r0 + tok) * NP + C_LR + cc); lrs[tok * 32 + cc] = bflo(w); lrs[tok * 32 + cc + 1] = bfhi(w); }
        __syncthreads();
        bf16 qraw[32], kraw[32];
        { const bf16* pq = P + r0 * NP + C_GQ + col;
#pragma unroll
          for (int t = 0; t < 32; ++t) { qraw[t] = pq[(size_t)t * NP]; kraw[t] = pq[(size_t)t * NP + (C_GK - C_GQ)]; } }
#pragma unroll 1
        for (int dir = 0; dir < 2; ++dir) {
            float wa[16];
#pragma unroll
            for (int r = 0; r < 16; ++r) wa[r] = inp(F, I_GWA)[((size_t)(layer * 2 + dir) * 16 + r) * 512 + col];
            const float ba = inp(F, I_GBA)[(layer * 2 + dir) * 512 + col];
#pragma unroll 2
            for (int t = 0; t < 32; ++t) { float z = ba;
#pragma unroll
                for (int r = 0; r < 16; ++r) z += lrs[t * 32 + dir * 16 + r] * wa[r];
                bbs[64 * t] = log_sigmoid_(z) * (1.0f / 16.0f); }
            float run = 0.f;
            if (dir == 0) {
#pragma unroll 4
                for (int t = 0; t < 32; ++t) { run += bbs[64 * t]; bbs[64 * t] = run; }
            } else {
#pragma unroll 4
                for (int t = 31; t >= 0; --t) { run += bbs[64 * t]; bbs[64 * t] = run; }
            }
            const float bend = run;
            bf16* QH = WSP(bf16, WS_QH) + (size_t)dir * MROWS * 512;
            bf16* KHT = WSP(bf16, WS_KHT) + ((((size_t)dir * 272 + it) * 8 + h) * 64 + lane) * 32;
#pragma unroll
            for (int tg = 0; tg < 4; ++tg) { unsigned kw[4];
#pragma unroll
                for (int i2 = 0; i2 < 4; ++i2) { float khv[2];
#pragma unroll
                    for (int e = 0; e < 2; ++e) { const int t = 8 * tg + 2 * i2 + e; const float bt = bbs[64 * t];
                        const float q = bf2f(qraw[t]) * 0.125f, k = bf2f(kraw[t]);
                        const float qh = q * __expf(bt), kt = k * __expf(-bt); khv[e] = k * __expf(bend - bt);
                        const bf16 qb = (bf16)f2bf(qh);
                        QH[(r0 + t) * 512 + col] = qb;
                        *(LAS bf16*)(tq + t * 144 + lane * 2) = qb; *(LAS bf16*)(tk + t * 144 + lane * 2) = (bf16)f2bf(kt); }
                    kw[i2] = pk2(khv[0], khv[1]); }
                *(GAS v4u*)(KHT + 8 * tg) = (v4u){kw[0], kw[1], kw[2], kw[3]}; }
            WSP(float, WS_DEC)[((size_t)dir * 272 + it) * 512 + col] = __expf(bend);
            LDS_WAIT(); asm volatile("" ::: "memory");
            bf16x8 af[2][2], bfr[2][2];
#pragma unroll
            for (int mb = 0; mb < 2; ++mb)
#pragma unroll
                for (int s = 0; s < 2; ++s) { af[mb][s] = *(const LAS bf16x8*)(tk + (16 * mb + fr) * 144 + 64 * s + 16 * fq); bfr[mb][s] = *(const LAS bf16x8*)(tq + (16 * mb + fr) * 144 + 64 * s + 16 * fq); }
            LDS_WAIT(); asm volatile("" ::: "memory");
            bf16* AM = WSP(bf16, WS_AM) + (((size_t)dir * 272 + it) * 8 + h) * 1024;
#pragma unroll
            for (int mb = 0; mb < 2; ++mb)
#pragma unroll
                for (int nb = 0; nb < 2; ++nb) { f32x4 dacc = {0.f, 0.f, 0.f, 0.f};
                    dacc = __builtin_amdgcn_mfma_f32_16x16x32_bf16(af[mb][0], bfr[nb][0], dacc, 0, 0, 0);
                    dacc = __builtin_amdgcn_mfma_f32_16x16x32_bf16(af[mb][1], bfr[nb][1], dacc, 0, 0, 0);
                    const int i = 16 * nb + fr, j0 = 16 * mb + 4 * fq; float vv[4];
#pragma unroll
                    for (int r = 0; r < 4; ++r) { const int j = j0 + r; const bool keep = dir == 0 ? (j <= i) : (j >= i); vv[r] = keep ? dacc[r] : 0.f; }
                    *(GAS v2u*)(AM + i * 32 + j0) = (v2u){pk2(vv[0], vv[1]), pk2(vv[2], vv[3])}; }
        }
#pragma unroll 1
        for (int half = 0; half < 2; ++half) { const int v = lane + 64 * half; bf16* VT = WSP(bf16, WS_VT) + (((size_t)it * 8 + h) * 128 + v) * 32;
            const bf16* pv = P + r0 * NP + C_GV + h * 128 + v;
            bf16 vr[32];
#pragma unroll
            for (int t = 0; t < 32; ++t) vr[t] = pv[(size_t)t * NP];
#pragma unroll
            for (int tg = 0; tg < 4; ++tg) *(GAS v4u*)(VT + 8 * tg) = (v4u){(unsigned)vr[8 * tg] | ((unsigned)vr[8 * tg + 1] << 16), (unsigned)vr[8 * tg + 2] | ((unsigned)vr[8 * tg + 3] << 16),
                                                                            (unsigned)vr[8 * tg + 4] | ((unsigned)vr[8 * tg + 5] << 16), (unsigned)vr[8 * tg + 6] | ((unsigned)vr[8 * tg + 7] << 16)}; }
    }
    __syncthreads();
}
constexpr int GLA_SLOT = 18688, GLA_R = 7, GLA_D = 6, GLA_JUNK = GLA_R * GLA_SLOT;
__device__ __forceinline__ int gla_chunk_of(int dir, int ci) { return dir == 0 ? ci : (ci < GNCTX ? GNCTX - 1 - ci : GNCH - 1 + GNCTX - ci); }
__device__ __forceinline__ void gla_issue(Ctx& F, int dir, int b, int h, int c, int slot) {
    const int lane = F.lane, w = F.wave; const int it = b * GNCH + c; const size_t di = (size_t)dir * 272 + it;
    LAS unsigned char* sl = F.lds + RING_OFF + slot * GLA_SLOT;
    const unsigned char* vt = (const unsigned char*)(WSP(bf16, WS_VT) + ((size_t)it * 8 + h) * 4096);
    __builtin_amdgcn_global_load_lds((const GAS unsigned*)(vt + 1024 * w + 16 * lane), (LAS unsigned*)(sl + 1024 * w), 16, 0, 0);
    if (w < 4) { const unsigned char* kh = (const unsigned char*)(WSP(bf16, WS_KHT) + (di * 8 + h) * 2048);
        __builtin_amdgcn_global_load_lds((const GAS unsigned*)(kh + 1024 * w + 16 * lane), (LAS unsigned*)(sl + 8192 + 1024 * w), 16, 0, 0); }
    else { const unsigned char* qh = (const unsigned char*)(WSP(bf16, WS_QH) + ((size_t)dir * MROWS + (size_t)b * RPB + (size_t)c * GCH + 8 * (w - 4) + (lane >> 3)) * 512 + h * 64);
        __builtin_amdgcn_global_load_lds((const GAS unsigned*)(qh + 16 * (lane & 7)), (LAS unsigned*)(sl + 12288 + 1024 * (w - 4)), 16, 0, 0); }
    if (w < 2) { const unsigned char* am = (const unsigned char*)(WSP(bf16, WS_AM) + (di * 8 + h) * 1024);
        __builtin_amdgcn_global_load_lds((const GAS unsigned*)(am + 1024 * w + 16 * lane), (LAS unsigned*)(sl + 16384 + 1024 * w), 16, 0, 0); }
    else if (w == 2) { const unsigned char* dc = (const unsigned char*)(WSP(float, WS_DEC) + di * 512 + h * 64);
        if (lane < 16) __builtin_amdgcn_global_load_lds((const GAS unsigned*)(dc + 16 * lane), (LAS unsigned*)(sl + 18432), 16, 0, 0); }
    else __builtin_amdgcn_global_load_lds((const GAS unsigned*)(vt + 16 * lane), (LAS unsigned*)(F.lds + RING_OFF + GLA_JUNK), 16, 0, 0);
}
__device__ __forceinline__ void gla_seq_job(Ctx& F, int layer, int job) {
    const int dir = job >> 4, b = (job >> 3) & 1, h = job & 7; const int lane = F.lane, fr = lane & 15, fq = lane >> 4, w = F.wave;
    f32x4 S[4];
#pragma unroll
    for (int m = 0; m < 4; ++m) S[m] = (f32x4){0.f, 0.f, 0.f, 0.f};
    float* GO = WSP(float, WS_GO) + (size_t)dir * MROWS * 1024;
    asm volatile("s_waitcnt vmcnt(0)" ::: "memory"); __builtin_amdgcn_s_barrier();
#pragma unroll 1
    for (int c0 = 0; c0 < GLA_D - 1; ++c0) gla_issue(F, dir, b, h, gla_chunk_of(dir, c0), c0);
    asm volatile("s_waitcnt vmcnt(0)" ::: "memory");
#pragma unroll 1
    for (int ci = 0; ci < GNCH; ++ci) {
        const int c = gla_chunk_of(dir, ci);
        { const int cn = ci + GLA_D - 1; gla_issue(F, dir, b, h, gla_chunk_of(dir, cn < GNCH ? cn : GNCH - 1), cn % GLA_R); }
        asm volatile("s_waitcnt vmcnt(55)" ::: "memory");
        __builtin_amdgcn_s_barrier(); asm volatile("" ::: "memory");
        const LAS unsigned char* sl = F.lds + RING_OFF + (ci % GLA_R) * GLA_SLOT;
        const bf16x8 vt = *(const LAS bf16x8*)(sl + (16 * w + fr) * 64 + 16 * fq);
        bf16x4 qa[2][2], qb[2][2]; bf16x8 am[2], kh[4]; f32x4 dec[4];
#pragma unroll
        for (int ib = 0; ib < 2; ++ib) {
#pragma unroll
            for (int s = 0; s < 2; ++s) { const LAS unsigned char* qp = sl + 12288 + (16 * ib + fr) * 128 + (32 * s + 4 * fq) * 2; qa[ib][s] = *(const LAS bf16x4*)qp; qb[ib][s] = *(const LAS bf16x4*)(qp + 32); }
            am[ib] = *(const LAS bf16x8*)(sl + 16384 + (16 * ib + fr) * 64 + 16 * fq); }
#pragma unroll
        for (int m = 0; m < 4; ++m) { dec[m] = *(const LAS f32x4*)(sl + 18432 + (16 * m + 4 * fq) * 4); kh[m] = *(const LAS bf16x8*)(sl + 8192 + (16 * m + fr) * 64 + 16 * fq); }
        bf16x8 sb[2];
#pragma unroll
        for (int s = 0; s < 2; ++s) { const v4u wv = (v4u){pg8::cvt_pk_bf16(S[2 * s][0], S[2 * s][1]), pg8::cvt_pk_bf16(S[2 * s][2], S[2 * s][3]), pg8::cvt_pk_bf16(S[2 * s + 1][0], S[2 * s + 1][1]), pg8::cvt_pk_bf16(S[2 * s + 1][2], S[2 * s + 1][3])};
            sb[s] = __builtin_bit_cast(bf16x8, wv); }
        asm volatile("s_waitcnt lgkmcnt(0)" ::: "memory"); __builtin_amdgcn_sched_barrier(0);
        f32x4 o[2];
#pragma unroll
        for (int ib = 0; ib < 2; ++ib) { o[ib] = (f32x4){0.f, 0.f, 0.f, 0.f};
#pragma unroll
            for (int s = 0; s < 2; ++s) { const bf16x8 qf = (bf16x8){qa[ib][s][0], qa[ib][s][1], qa[ib][s][2], qa[ib][s][3], qb[ib][s][0], qb[ib][s][1], qb[ib][s][2], qb[ib][s][3]};
                o[ib] = __builtin_amdgcn_mfma_f32_16x16x32_bf16(qf, sb[s], o[ib], 0, 0, 0); } }
#pragma unroll
        for (int m = 0; m < 4; ++m) { S[m] = S[m] * dec[m]; S[m] = __builtin_amdgcn_mfma_f32_16x16x32_bf16(kh[m], vt, S[m], 0, 0, 0); }
#pragma unroll
        for (int ib = 0; ib < 2; ++ib) { o[ib] = __builtin_amdgcn_mfma_f32_16x16x32_bf16(am[ib], vt, o[ib], 0, 0, 0);
            float* op = GO + ((size_t)b * RPB + (size_t)c * GCH + 16 * ib + 4 * fq) * 1024 + h * 128 + 16 * w + fr;
#pragma unroll
            for (int r = 0; r < 4; ++r) op[(size_t)r * 1024] = o[ib][r]; }
    }
    asm volatile("s_waitcnt vmcnt(0)" ::: "memory"); __builtin_amdgcn_s_barrier();
}
__device__ __forceinline__ void ph_gla_post(Ctx& F, int layer, int nu) {
    if (F.bid < nu) return;
    const int gw = (F.bid - nu) * NWAVES + F.wave, NGW = (F.G - nu) * NWAVES; const int lane = F.lane;
    const float* g0 = WSP(float, WS_GO); const float* g1 = g0 + (size_t)MROWS * 1024; const bf16* P = WSP(bf16, WS_P);
    const float* go = inp(F, I_GNORM) + layer * 128;
    const float gg0 = go[2 * lane], gg1 = go[2 * lane + 1];
    for (int it = gw; it < MROWS * 8; it += NGW) {
        const int r = it >> 3, h = it & 7; if (layer == 1 && (r % RPB) < TC) continue;
        const size_t o = (size_t)r * 1024 + h * 128 + 2 * lane;
        const f32x2 a = *(const GAS f32x2*)(g0 + o), bq = *(const GAS f32x2*)(g1 + o);
        const float y0 = a.x + bq.x, y1 = a.y + bq.y;
        const float rstd = 1.0f / sqrtf(wave_sum(y0 * y0 + y1 * y1) * (1.0f / 128.0f) + EPS);
        const unsigned zw = *(const GAS unsigned*)(P + (size_t)r * NP + C_GZ + h * 128 + 2 * lane);
        *(GAS unsigned*)(WSP(bf16, WS_ACAT) + (size_t)r * DM + 1024 + h * 128 + 2 * lane) = pk2(y0 * rstd * gg0 * bflo(zw), y1 * rstd * gg1 * bfhi(zw));
    }
}
__device__ __forceinline__ void ph_attn_gate(Ctx& F, int layer) {
    const bf16* P = WSP(bf16, WS_P); bf16* AT = WSP(bf16, WS_AT);
    for (size_t e = (size_t)F.bid * NTHR + F.tid; e < (size_t)MROWS * 256; e += (size_t)F.G * NTHR) {
        const size_t r = e >> 8; const int c8 = (int)(e & 255) * 8; if (layer == 1 && (r % RPB) < TC) continue;
        const v4u a = *(const GAS v4u*)(AT + r * 2048 + c8), g = *(const GAS v4u*)(P + r * NP + C_AZ + c8);
        v4u o; o.x = pk2(bflo(a.x) * bflo(g.x), bfhi(a.x) * bfhi(g.x)); o.y = pk2(bflo(a.y) * bflo(g.y), bfhi(a.y) * bfhi(g.y));
        o.z = pk2(bflo(a.z) * bflo(g.z), bfhi(a.z) * bfhi(g.z)); o.w = pk2(bflo(a.w) * bflo(g.w), bfhi(a.w) * bfhi(g.w));
        *(GAS v4u*)(WSP(bf16, WS_ACAT) + r * DM + 2048 + c8) = o;
    }
}
__device__ __forceinline__ int s5_jrow(int dir, int so) { return dir == 0 ? so : (so < TC ? TC - 1 - so : RPB + TC - 1 - so); }
__device__ __forceinline__ int s5_uoff(int j) { return (j * 32) ^ (((j >> 4) & 7) << 5); }
constexpr int S5_XCH_OFF = RPB * 32;
__device__ __forceinline__ void s5_job(Ctx& F, int layer, int job) {
    const int b = job >> 6, g = job & 63; const int lane = F.lane, fr = lane & 15, fq = lane >> 4, w = F.wave;
    const bf16* P = WSP(bf16, WS_P);
    LAS unsigned char* UL = F.lds + RING_OFF; LAS f32x2* XCH = (LAS f32x2*)(F.lds + RING_OFF + S5_XCH_OFF);
    float* E = WSP(float, WS_E) + (size_t)job * SNCH * 128; bf16* HS = WSP(bf16, WS_HS) + (size_t)job * SNCH * 128;
    float* YF = WSP(float, WS_YF); bf16* GB = WSP(bf16, WS_GB);
    __syncthreads();
    { v4u uv[17];
#pragma unroll
      for (int q = 0; q < 17; ++q) { const int idx = F.tid + 512 * q; uv[q] = *(const GAS v4u*)(WSP(bf16, WS_UB) + ((size_t)b * 64 + g) * RPB * 16 + (size_t)idx * 8); }
#pragma unroll
      for (int q = 0; q < 17; ++q) { const int idx = F.tid + 512 * q; *(LAS v4u*)(UL + s5_uoff(idx >> 1) + (idx & 1) * 16) = uv[q]; } }
    __syncthreads();
#pragma unroll 1
    for (int dir = 0; dir < 2; ++dir) {
        const int item = (layer * 2 + dir) * 64 + g;
        const bf16* TG = WSP(bf16, WS_TG) + (size_t)item * 256 * 384; const bf16* WT = WSP(bf16, WS_WT) + (size_t)item * 128 * 256; const float* L16 = WSP(float, WS_L16) + (size_t)item * 128;
        {
            bf16x8 bw[8];
#pragma unroll
            for (int s = 0; s < 8; ++s) bw[s] = *(const GAS bf16x8*)(WT + (size_t)(16 * w + fr) * 256 + 32 * s + 8 * fq);
#pragma unroll 1
            for (int mb_ = 0; mb_ < 17; ++mb_) { int mb = mb_; asm volatile("" : "+s"(mb)); f32x4 acc = {0.f, 0.f, 0.f, 0.f}; const int k = 16 * mb + fr;
#pragma unroll
                for (int s = 0; s < 8; ++s) { const bf16x8 a = *(const LAS bf16x8*)(UL + s5_uoff(s5_jrow(dir, 16 * k + 2 * s + (fq >> 1))) + (fq & 1) * 16); acc = __builtin_amdgcn_mfma_f32_16x16x32_bf16(a, bw[s], acc, 0, 0, 0); }
#pragma unroll
                for (int r = 0; r < 4; ++r) E[(size_t)(16 * mb + 4 * fq + r) * 128 + 16 * w + fr] = acc[r]; }
        }
        VM_WAIT(); __syncthreads();
        { const float pr = L16[2 * lane], pi = L16[2 * lane + 1]; const int k0 = 34 * w;
            float er[34], ei[34];
            { const float* ep = E + (size_t)k0 * 128 + 2 * lane;
#pragma unroll
              for (int q = 0; q < 34; ++q) { const f32x2 t = *(const GAS f32x2*)ep; er[q] = t.x; ei[q] = t.y; ep += 128; asm volatile("" : "+v"(ep)); } }
            float lr = 0.f, li = 0.f;
#pragma unroll
            for (int q = 0; q < 34; ++q) { const float tx = er[q], ty = ei[q]; er[q] = lr; ei[q] = li; const float nr = pr * lr - pi * li + tx, ni = pr * li + pi * lr + ty; lr = nr; li = ni; }
            float qr = pr, qi = pi, p2r, p2i;
            { float tr = qr * qr - qi * qi, ti = 2.f * qr * qi; qr = tr; qi = ti; p2r = qr; p2i = qi; }
#pragma unroll
            for (int q = 0; q < 4; ++q) { const float tr = qr * qr - qi * qi, ti = 2.f * qr * qi; qr = tr; qi = ti; }
            const float p34r = qr * p2r - qi * p2i, p34i = qr * p2i + qi * p2r;
            XCH[w * 64 + lane] = (f32x2){lr, li};
            LDS_WAIT(); __syncthreads();
            float cr = 0.f, ci = 0.f;
            for (int v = 0; v < w; ++v) { const f32x2 x = XCH[v * 64 + lane]; const float nr = p34r * cr - p34i * ci + x.x, ni = p34r * ci + p34i * cr + x.y; cr = nr; ci = ni; }
            float wr_ = 1.f, wi_ = 0.f; bf16* hp = HS + (size_t)k0 * 128 + 2 * lane;
#pragma unroll
            for (int q = 0; q < 34; ++q) { const float hr = wr_ * cr - wi_ * ci + er[q], hi = wr_ * ci + wi_ * cr + ei[q];
                *(GAS unsigned*)hp = pk2(hr, hi); hp += 128; asm volatile("" : "+v"(hp));
                const float nr = wr_ * pr - wi_ * pi, ni = wr_ * pi + wi_ * pr; wr_ = nr; wi_ = ni; } }
        VM_WAIT(); __syncthreads();
        {
            bf16x8 bt[2][12];
#pragma unroll
            for (int nb = 0; nb < 2; ++nb)
#pragma unroll
                for (int s = 0; s < 12; ++s) bt[nb][s] = *(const GAS bf16x8*)(TG + (size_t)((2 * w + nb) * 16 + fr) * 384 + 32 * s + 8 * fq);
            const float dsk = inp(F, I_SSMD)[layer * 1024 + g * 16 + fr];
            bf16x8 hn[4], hn2[4]; float yn[2][4];
#pragma unroll
            for (int s = 0; s < 4; ++s) { hn[s] = *(const GAS bf16x8*)(HS + (size_t)fr * 128 + 32 * s + 8 * fq); hn2[s] = *(const GAS bf16x8*)(HS + (size_t)(16 + fr) * 128 + 32 * s + 8 * fq); }
#pragma unroll
            for (int nb = 0; nb < 2; ++nb)
#pragma unroll
                for (int r = 0; r < 4; ++r) { yn[nb][r] = 0.f; if (dir == 1) yn[nb][r] = YF[(((size_t)b * 64 + g) * RPB + s5_jrow(1, 16 * (4 * fq + r) + 2 * w + nb)) * 16 + fr]; }
#pragma unroll 1
            for (int mb_ = 0; mb_ < 17; ++mb_) { int mb = mb_; asm volatile("" : "+s"(mb)); f32x4 acc[2]; acc[0] = (f32x4){0.f, 0.f, 0.f, 0.f}; acc[1] = acc[0]; const int k = 16 * mb + fr;
                bf16x8 hc[4]; float yc[2][4];
#pragma unroll
                for (int s = 0; s < 4; ++s) { hc[s] = hn[s]; hn[s] = hn2[s]; }
#pragma unroll
                for (int nb = 0; nb < 2; ++nb)
#pragma unroll
                    for (int r = 0; r < 4; ++r) yc[nb][r] = yn[nb][r];
                { const int mn = mb + 2 < 17 ? mb + 2 : 16, m1 = mb + 1 < 17 ? mb + 1 : 16;
#pragma unroll
                  for (int s = 0; s < 4; ++s) hn2[s] = *(const GAS bf16x8*)(HS + (size_t)(16 * mn + fr) * 128 + 32 * s + 8 * fq);
                  if (dir == 1) {
#pragma unroll
                    for (int nb = 0; nb < 2; ++nb)
#pragma unroll
                        for (int r = 0; r < 4; ++r) yn[nb][r] = YF[(((size_t)b * 64 + g) * RPB + s5_jrow(1, 16 * (16 * m1 + 4 * fq + r) + 2 * w + nb)) * 16 + fr]; } }
#pragma unroll
                for (int s = 0; s < 12; ++s) { bf16x8 a;
                    if (s < 8) a = *(const LAS bf16x8*)(UL + s5_uoff(s5_jrow(dir, 16 * k + 2 * s + (fq >> 1))) + (fq & 1) * 16); else a = hc[s - 8];
                    acc[0] = __builtin_amdgcn_mfma_f32_16x16x32_bf16(a, bt[0][s], acc[0], 0, 0, 0); acc[1] = __builtin_amdgcn_mfma_f32_16x16x32_bf16(a, bt[1][s], acc[1], 0, 0, 0);
                    if (s == 3 || s == 7) asm volatile("" ::: "memory"); }
#pragma unroll
                for (int nb = 0; nb < 2; ++nb)
#pragma unroll
                    for (int r = 0; r < 4; ++r) { const int jr = s5_jrow(dir, 16 * (16 * mb + 4 * fq + r) + 2 * w + nb); const size_t o = ((size_t)b * RPB + jr) * 1024 + g * 16 + fr;
                        if (dir == 0) YF[(((size_t)b * 64 + g) * RPB + jr) * 16 + fr] = acc[nb][r];
                        else { const float u = bf2f(*(const LAS bf16*)(UL + s5_uoff(jr) + fr * 2)); GB[o] = (bf16)f2bf(gelu_tanh(acc[nb][r] + yc[nb][r] + dsk * u)); } } }
        }
        VM_WAIT(); __syncthreads();
    }
}
__device__ __forceinline__ void attn_unit(Ctx& F, int b, int h, size_t qrow, int seq) {
    att::attn_dense_body<att::bf16>((const att::bf16*)(WSP(bf16, WS_QN) + qrow * 2048 + h * 128), (const att::bf16*)(WSP(bf16, WS_KN) + (size_t)b * RPB * 512 + (h >> 2) * 128),
        (const att::bf16*)(WSP(bf16, WS_VN) + (size_t)b * RPB * 512 + (h >> 2) * 128), WSP(bf16, WS_AT) + qrow * 2048 + h * 128, seq, (char*)(F.lds + RING_OFF), F.tid);
    VM_WAIT(); __syncthreads();
    { const bf16* P = WSP(bf16, WS_P); const bf16* AT = WSP(bf16, WS_AT); bf16* AC = WSP(bf16, WS_ACAT);
#pragma unroll
      for (int q = 0; q < 8; ++q) { const int e = F.tid + 512 * q; const size_t r = qrow + (e >> 4); const int c8 = h * 128 + (e & 15) * 8;
        const v4u a = *(const GAS v4u*)(AT + r * 2048 + c8), g = *(const GAS v4u*)(P + r * NP + C_AZ + c8);
        v4u o; o.x = pk2(bflo(a.x) * bflo(g.x), bfhi(a.x) * bfhi(g.x)); o.y = pk2(bflo(a.y) * bflo(g.y), bfhi(a.y) * bfhi(g.y));
        o.z = pk2(bflo(a.z) * bflo(g.z), bfhi(a.z) * bfhi(g.z)); o.w = pk2(bflo(a.w) * bflo(g.w), bfhi(a.w) * bfhi(g.w));
        *(GAS v4u*)(AC + r * DM + 2048 + c8) = o; } }
}

__device__ __forceinline__ void ph_inproj_reduce(Ctx& F) {
    pg8::InProjOrder O; O.init(MROWS, NP, F.G, F.bid, 1, 1 << 30);
    const float* PT = WSP(float, WS_PARTP); bf16* P = WSP(bf16, WS_P); bf16* UB = WSP(bf16, WS_UB);
    for (int it = F.bid * NTHR + F.tid; it < 62 * 8192; it += F.G * NTHR) {
        const int e = it >> 13, rr = (it >> 5) & 255, c8 = (it & 31) * 8;
        pg8::Unit u; O.at(2816 + e, u);
        f32x4 v0 = {0.f, 0.f, 0.f, 0.f}, v1 = v0;
#pragma unroll
        for (int ks = 0; ks < 4; ++ks) { const float* pp = PT + ((size_t)(e * 4 + ks) * 256 + rr) * 256 + c8; v0 += *(const GAS f32x4*)pp; v1 += *(const GAS f32x4*)(pp + 4); }
        const int pn = u.pn; const int act = (pn >= 40 && pn < 88) ? 2 : (((pn >= 4 && pn < 8) || (pn >= 16 && pn < 20) || (pn >= 32 && pn < 40)) ? 1 : 0);
        if (act == 1) {
#pragma unroll
            for (int j = 0; j < 4; ++j) { v0[j] = siluf_(v0[j]); v1[j] = siluf_(v1[j]); } }
        else if (act == 2) {
#pragma unroll
            for (int j = 0; j < 4; ++j) { v0[j] = sigmoidf_(v0[j]); v1[j] = sigmoidf_(v1[j]); } }
        const v4u o = (v4u){pk2(v0[0], v0[1]), pk2(v0[2], v0[3]), pk2(v1[0], v1[1]), pk2(v1[2], v1[3])};
        const int row = u.pm * 256 + rr, col = pn * 256 + c8;
        if (pn < 4) { const int bb = u.pm / 17, jj = (u.pm % 17) * 256 + rr; *(GAS v4u*)(UB + (((size_t)bb * 64 + (col >> 4)) * RPB + jj) * 16 + (col & 15)) = o; }
        else *(GAS v4u*)(P + (size_t)row * NP + col) = o;
    }
}
#ifndef REP_PRO
#define REP_PRO 1
#endif
#ifndef REP_INPROJ
#define REP_INPROJ 1
#endif
#ifndef REP_PREP
#define REP_PREP 1
#endif
#ifndef REP_MIX
#define REP_MIX 1
#endif
#ifndef REP_S5
#define REP_S5 1
#endif
#ifndef REP_GSEQ
#define REP_GSEQ 1
#endif
#ifndef REP_ATT
#define REP_ATT 1
#endif
#ifndef REP_MERGE
#define REP_MERGE 1
#endif
#ifndef REP_NORM
#define REP_NORM 1
#endif
constexpr int ST_PRO = 0, ST_MODR = 1, ST_L0 = 2, ST_PER_L = 7, ST_FINAL = ST_L0 + 2 * ST_PER_L, NSTEPS = ST_FINAL + 1;
struct Args { const float* in[N_IN]; float* out; unsigned char* ws; int lo, hi, li, pad; };
__global__ void __launch_bounds__(NTHR, 2) fwd(Args args) {
    extern __shared__ __attribute__((aligned(16))) unsigned char lds[];
    Ctx F;
    F.lds = (LAS unsigned char*)lds;
    F.MISC = (volatile LAS unsigned*)(F.lds + MISC_OFF);
    F.tid = threadIdx.x; F.lane = F.tid & 63; F.wave = __builtin_amdgcn_readfirstlane(F.tid >> 6);
    F.G = gridDim.x; F.bid = blockIdx.x;
    F.ws = args.ws; F.out = args.out; F.ctl = (gu32*)(args.ws + WS_CTL);
    for (int u = F.tid; u < (LDS_BYTES - LDSCTL_OFF) / 4; u += NTHR) ((LAS unsigned*)(F.lds + LDSCTL_OFF))[u] = 0u;
    __syncthreads();
    if (F.tid < N_IN) *(LAS unsigned long long*)(F.lds + INTAB_OFF + 8 * F.tid) = (unsigned long long)args.in[F.tid];
    __syncthreads();
    XcdBarrier bar = xcd_barrier_post((unsigned*)(F.ctl + CW_BAR) + args.li * XCD_BAR_WORDS, F.MISC + 8);
    const int lo = args.lo, hi = args.hi; const int wave0 = F.wave;
#define IN(k) (lo <= (k) && (k) < hi)
#define REFRESH() do { int w_ = wave0; asm volatile("" : "+s"(w_)); int l_; asm volatile("v_mbcnt_lo_u32_b32 %0, -1, 0\n\tv_mbcnt_hi_u32_b32 %0, -1, %0" : "=v"(l_)); F.wave = w_; F.lane = l_; F.tid = w_ * 64 + l_; } while (0)
#define SEAM(k) do { if (IN(k) && IN((k) + 1)) xcd_barrier(bar); } while (0)

    if (IN(ST_PRO)) for (int rep_ = 0; rep_ < REP_PRO; ++rep_) { REFRESH();
#ifndef DIS_PRO
 ph_rope_table(F);
            { const int NL1 = (F.G == 256) ? 322 : 0, NMEM = 384 + TJ_JOBS + NL1, NJ = NMEM + 256;
              for (;;) {
                __syncthreads();
                if (F.tid == 0) F.MISC[16] = __hip_atomic_fetch_add((unsigned*)(F.ctl + CW_TQ + 64 * (5 + 8 * rep_)), 1u, RLX_AGENT);
                __syncthreads();
                const int j = (int)F.MISC[16];
                if (j >= NJ) break;
                REFRESH();
                const int stride = NJ / 256, s = j / stride;
                if (j % stride == 0 && s < 256) { s5_mats_item(F, s); continue; }
                const int m = j - (s + 1 < 256 ? s + 1 : 256);
                if (m < 384) mod_partial_item(F, m);
                else if (m < 384 + TJ_JOBS) transpose_job(F, 0, m - 384);
                else transpose_job(F, 1, m - 384 - TJ_JOBS);
              } }
#endif
 }
    SEAM(ST_PRO);
    if (IN(ST_MODR)) { REFRESH(); ph_mod_reduce(F); }
    SEAM(ST_MODR);
#pragma unroll 1
    for (int l = 0; l < 2; ++l) {
        const int sb = ST_L0 + ST_PER_L * l;
        if (IN(sb + 0)) for (int rep_ = 0; rep_ < REP_NORM; ++rep_) { REFRESH();
#ifndef DIS_NORM
 ph_norm(F, l, F.G == 256);
#endif
 }
        SEAM(sb + 0);
        if (IN(sb + 1)) for (int rep_ = 0; rep_ < REP_INPROJ; ++rep_) { REFRESH();
            pg8::Gemm g{WSP(bf16, WS_H), WSP(bf16, WS_WIN) + (size_t)l * NP * DM, MROWS, NP, DM, DM, DM}; const bool ksplit = (l == 1 && F.G == 256 && lo == 0 && hi == NSTEPS);
            pg8::InProjOrder S; S.init(MROWS, NP, F.G, F.bid, l, ksplit ? 11 : (1 << 30));
            pg8::EpiInProj E{WSP(bf16, WS_P), WSP(bf16, WS_UB)};
#ifndef DIS_G1
            pg8::gemm_phase<pg8::EpiInProj, pg8::InProjOrder, true, true>(F.lds + RING_OFF, g, S, E, F.tid);
#endif
            if (ksplit) { REFRESH();
                pg8::Gemm g2{WSP(bf16, WS_H), WSP(bf16, WS_WIN) + (size_t)l * NP * DM, MROWS, NP, 1024, DM, DM}; pg8::InProjSplitOrder S2; S2.init(MROWS, NP, F.G, F.bid);
                pg8::EpiPartial E2{WSP(float, WS_PARTP)};
                pg8::gemm_phase<pg8::EpiPartial, pg8::InProjSplitOrder, true, true>(F.lds + RING_OFF, g2, S2, E2, F.tid);
                xcd_barrier(bar); REFRESH(); ph_inproj_reduce(F); }
        }
        SEAM(sb + 1);
        if (IN(sb + 2)) for (int rep_ = 0; rep_ < REP_PREP; ++rep_) { REFRESH();
            for (;;) {
                __syncthreads();
                if (F.tid == 0) F.MISC[16] = __hip_atomic_fetch_add((unsigned*)(F.ctl + CW_PQ + 64 * (l + 2 * rep_)), 1u, RLX_AGENT);
                __syncthreads();
                const int j = (int)F.MISC[16];
                if (j >= NB * GNCH + MROWS / 8) break;
                REFRESH();
                if (j < NB * GNCH) gla_prep_item(F, l, j); else attn_prep_rows(F, l, (j - NB * GNCH) * 8, (j - NB * GNCH) * 8 + 8);
            }
 }
        SEAM(sb + 2);
        if (IN(sb + 3)) for (int rep_ = 0; rep_ < REP_MIX; ++rep_) { REFRESH();
            const int n_ctx = (l == 0) ? 32 : 0, n_jobs = 160 + n_ctx + 512;
            for (;;) {
                __syncthreads();
                if (F.tid == 0) F.MISC[16] = __hip_atomic_fetch_add((unsigned*)(F.ctl + CW_QUEUE + 64 * (l + 2 * rep_)), 1u, RLX_AGENT);
                __syncthreads();
                const int j = (int)F.MISC[16];
                if (j >= n_jobs) break;
                REFRESH();
                if (j < 32) {
#ifndef DIS_GSEQ
                    for (int rs_ = 0; rs_ < REP_GSEQ; ++rs_) gla_seq_job(F, l, j);
#endif
                } else if (j < 160) {
#ifndef DIS_S5
                    for (int rs_ = 0; rs_ < REP_S5; ++rs_) s5_job(F, l, j - 32);
#endif
                } else { const int u = j - 160; const bool isc = u >= 512; const int uu = isc ? u - 512 : u;
                    const int b = isc ? (uu >> 4) : (uu >> 8), h = isc ? (uu & 15) : ((uu >> 4) & 15), qb = uu & 15;
#ifndef DIS_ATT
                    for (int ra_ = 0; ra_ < REP_ATT; ++ra_) { if (ra_) { __syncthreads(); REFRESH(); } attn_unit(F, b, h, (size_t)b * RPB + (isc ? 0 : TC + qb * 256), isc ? TC : RPB); }
#endif
                }
            }
#if REP_MIX > 1
            if (rep_ + 1 < REP_MIX) xcd_barrier(bar);
#endif
        }
        SEAM(sb + 3);
        if (IN(sb + 4)) for (int rep_ = 0; rep_ < REP_MERGE; ++rep_) { REFRESH();
#ifndef DIS_GPOST
            ph_gla_post(F, l, (l == 1 && F.G == 256) ? 128 : 0);
#endif
            pg8::Gemm g{WSP(bf16, WS_GB), WSP(bf16, WS_WGLU) + (size_t)l * 1024 * 1024, MROWS, 1024, 1024, 1024, 1024}; pg8::RowOrder S; S.init(MROWS, 1024, F.G, F.bid, l);
            pg8::EpiGlu E{WSP(bf16, WS_GB), WSP(bf16, WS_P), WSP(bf16, WS_ACAT)};
#ifndef DIS_G2
            pg8::gemm_phase<pg8::EpiGlu, pg8::RowOrder, true, true>(F.lds + RING_OFF, g, S, E, F.tid);
#endif
            if (l == 0) { REFRESH(); transposes_fill(F, (unsigned*)(F.ctl + CW_TQ + 64 * (0 + 8 * rep_)), 322, 552); }
        }
        SEAM(sb + 4);
        if (IN(sb + 5)) for (int rep_ = 0; rep_ < REP_MERGE; ++rep_) { REFRESH();
            pg8::RowOrder S; S.init(MROWS, DM, F.G, F.bid, l);
            pg8::Gemm g{WSP(bf16, WS_ACAT), WSP(bf16, WS_WCAT) + (size_t)l * DM * DM, MROWS, DM, DM, DM, DM};
            pg8::EpiProjCat E{WSP(bf16, WS_P), WSP(bf16, WS_MRG)};
#ifndef DIS_G3
            pg8::gemm_phase<pg8::EpiProjCat, pg8::RowOrder, true, true>(F.lds + RING_OFF, g, S, E, F.tid);
#endif
            if (l == 0) { REFRESH(); transposes_fill(F, (unsigned*)(F.ctl + CW_TQ + 64 * (1 + 8 * rep_)), 552, 1952); }
        }
        SEAM(sb + 5);
        if (IN(sb + 6)) for (int rep_ = 0; rep_ < REP_MERGE; ++rep_) { REFRESH();
            const bool ctxsplit = (l == 0 && F.G == 256);
            pg8::Gemm g{WSP(bf16, WS_MRG), WSP(bf16, WS_WO) + (size_t)l * DM * DM, MROWS, DM, DM, DM, DM}; pg8::RowOrder S; S.init(MROWS, DM, F.G, F.bid, (l == 1 || ctxsplit) ? 1 : 0);
            pg8::EpiOut E{inp(F, I_X), inp(F, I_CTX), WSP(float, WS_X1), F.out, WSP(float, WS_MOD) + (size_t)l * 3 * 12288, l};
#ifndef DIS_G4
            pg8::gemm_phase<pg8::EpiOut, pg8::RowOrder, true, true>(F.lds + RING_OFF, g, S, E, F.tid);
#endif
            if (ctxsplit) { REFRESH();
                pg8::Gemm g2{WSP(bf16, WS_MRG), WSP(bf16, WS_WO), MROWS, DM, 512, DM, DM}; pg8::CtxSplitOrder S2; S2.init(F.G, F.bid);
                pg8::EpiOutCtxPartial E2{WSP(float, WS_PART)};
                pg8::gemm_phase<pg8::EpiOutCtxPartial, pg8::CtxSplitOrder, true, true>(F.lds + RING_OFF, g2, S2, E2, F.tid); }
            if (l == 0 && !ctxsplit) { REFRESH(); transposes_fill(F, (unsigned*)(F.ctl + CW_TQ + 64 * (4 + 8 * rep_)), 0, 322); }
        }
        SEAM(sb + 6);
    }
    if (IN(ST_FINAL)) { REFRESH();
#ifndef DIS_FINAL
 ph_final(F);
#endif
 }
#undef IN
#undef REFRESH
#undef SEAM
}

#ifndef MK_ONE_LAUNCH
#define MK_ONE_LAUNCH 1
#endif
extern "C" void kernel_launch(void* const* d_in, const int* in_sizes, int n_in, void* d_out, int out_size, void* d_ws, size_t ws_size, hipStream_t stream) {
    static int grid = 0;
    if (grid == 0) {
        if (n_in != N_IN || in_sizes[0] != NB * TL * DM || out_size != NB * TL * DM || ws_size < WS_END) {
            fprintf(stderr, "kernel_launch: shape mismatch: n_in %d in0 %d out %d ws %zu (need %zu); nothing launched\n", n_in, n_in > 0 ? in_sizes[0] : -1, out_size, ws_size, (size_t)WS_END); grid = -1; return; }
        int dev = 0, cus = 0, per_cu = 0;
        if (hipGetDevice(&dev) != hipSuccess || hipDeviceGetAttribute(&cus, hipDeviceAttributeMultiprocessorCount, dev) != hipSuccess) { fprintf(stderr, "kernel_launch: device query failed\n"); grid = -1; return; }
        if (hipFuncSetAttribute((const void*)fwd, hipFuncAttributeMaxDynamicSharedMemorySize, LDS_BYTES) != hipSuccess) { fprintf(stderr, "kernel_launch: hipFuncSetAttribute failed\n"); grid = -1; return; }
        if (hipOccupancyMaxActiveBlocksPerMultiprocessor(&per_cu, (const void*)fwd, NTHR, LDS_BYTES) != hipSuccess || per_cu < 1)
            fprintf(stderr, "kernel_launch: note: occupancy query reports %d workgroups per CU\n", per_cu);
        (void)hipGetLastError();
        grid = cus;
    }
    if (grid < 0) return;
    if (hipMemsetAsync((char*)d_ws + WS_CTL, 0, CTL_ZERO_BYTES, stream) != hipSuccess) { fprintf(stderr, "kernel_launch: memset failed\n"); return; }
    Args a{};
    for (int i = 0; i < N_IN; ++i) a.in[i] = (const float*)d_in[i];
    a.out = (float*)d_out; a.ws = (unsigned char*)d_ws; a.pad = 0;
#if MK_ONE_LAUNCH
    a.lo = 0; a.hi = NSTEPS; a.li = 0;
    hipLaunchKernelGGL(fwd, dim3(grid), dim3(NTHR), LDS_BYTES, stream, a);
#else
    for (int s = 0; s < NSTEPS; ++s) { a.lo = s; a.hi = s + 1; a.li = s; hipLaunchKernelGGL(fwd, dim3(grid), dim3(NTHR), LDS_BYTES, stream, a); }
#endif
    const hipError_t le = hipPeekAtLastError();
    if (le != hipSuccess) fprintf(stderr, "kernel_launch: launch failed: %s\n", hipGetErrorName(le));
}
```

```cpp
#include <hip/hip_runtime.h>
#include <hip/hip_bf16.h>
#include <cstdio>
#include <cstdint>

#define GAS __attribute__((address_space(1)))
#define LAS __attribute__((address_space(3)))
typedef unsigned short bf16;
typedef unsigned v4u __attribute__((ext_vector_type(4)));
typedef unsigned v2u __attribute__((ext_vector_type(2)));
typedef float f32x4 __attribute__((ext_vector_type(4)));
typedef float f32x2 __attribute__((ext_vector_type(2)));
typedef short bf16x8 __attribute__((ext_vector_type(8)));
typedef short bf16x4 __attribute__((ext_vector_type(4)));
typedef GAS unsigned gu32;

constexpr int DM = 4096, NB = 2, TL = 4096, TC = 256, RPB = TC + TL  , MROWS = NB * RPB  ;
constexpr int NIN = 22560, NP = 22784  ;
constexpr int C_SU = 0, C_SZ = 1024, C_GQ = 2048, C_GK = 2560, C_GV = 3072, C_GZ = 4096, C_AQ = 5120, C_AK = 7168, C_AV = 7680, C_AZ = 8192, C_MG = 10240, C_LR = 22528;
constexpr int SSM_W = 1024, GLA_KW = 512, GLA_VW = 1024, ATT_QW = 2048, ATT_KVW = 512;
constexpr float EPS = 1e-6f;
constexpr int NWAVES = 8, NTHR = 512;
constexpr int GCH = 32  , GNCH = RPB / GCH  , GNCTX = TC / GCH  ;
constexpr int SCH = 16  , SNCH = RPB / SCH  ;

enum { I_X = 0, I_C, I_CTX, I_CCTX, I_NORMG, I_WMOD, I_BMOD, I_WIN, I_LAMRE, I_LAMIM, I_LOGDT, I_BRE, I_BIM, I_CRE, I_CIM, I_SSMD, I_WGLU, I_GWA, I_GBA, I_GNORM,
       I_AQG, I_AKG, I_WPS, I_WPG, I_WPA, I_WOUT, I_FINALG, N_IN };

constexpr size_t al256(size_t x) { return (x + 255) / 256 * 256; }
constexpr size_t WS_CTL = 0, CTL_ZERO_BYTES = 1u << 20;
constexpr size_t WS_MODP = WS_CTL + CTL_ZERO_BYTES;
constexpr size_t WS_MOD = WS_MODP + al256((size_t)2 * 32 * 3 * 12288 * 4);
constexpr size_t WS_ROPE = WS_MOD + al256((size_t)2 * 3 * 12288 * 4);
constexpr size_t WS_WIN = WS_ROPE + al256((size_t)2 * 64 * 32 * 4);
constexpr size_t WS_WGLU = WS_WIN + al256((size_t)2 * NP * DM * 2);
constexpr size_t WS_WPS = WS_WGLU + al256((size_t)2 * 1024 * 1024 * 2);
constexpr size_t WS_WPG = WS_WPS + al256((size_t)2 * 4096 * 1024 * 2);
constexpr size_t WS_WPA = WS_WPG + al256((size_t)2 * 4096 * 1024 * 2);
constexpr size_t WS_WO = WS_WPA + al256((size_t)2 * 4096 * 2048 * 2);
constexpr size_t WS_TG = WS_WO + al256((size_t)2 * 4096 * 4096 * 2);
constexpr size_t WS_WT = WS_TG + al256((size_t)2 * 2 * 64 * 256 * 384 * 2);
constexpr size_t WS_L16 = WS_WT + al256((size_t)2 * 2 * 64 * 128 * 256 * 2);
constexpr size_t WS_H = WS_L16 + al256((size_t)2 * 2 * 64 * 64 * 2 * 4);
constexpr size_t WS_P = WS_H + al256((size_t)MROWS * DM * 2);
constexpr size_t WS_X1 = WS_P + al256((size_t)MROWS * NP * 2);
constexpr size_t WS_QN = WS_X1 + al256((size_t)MROWS * DM * 4);
constexpr size_t WS_KN = WS_QN + al256((size_t)MROWS * 2048 * 2);
constexpr size_t WS_E = WS_KN + al256((size_t)MROWS * 512 * 2);
constexpr size_t WS_HS = WS_E + al256((size_t)128 * SNCH * 128 * 4);
constexpr size_t WS_YF = WS_HS + al256((size_t)128 * SNCH * 128 * 2);
constexpr size_t WS_GB = WS_YF + al256((size_t)MROWS * 1024 * 4);
constexpr size_t WS_SB = WS_GB + al256((size_t)MROWS * 1024 * 2);
constexpr size_t WS_GL = WS_SB + al256((size_t)MROWS * 1024 * 2);
constexpr size_t WS_AT = WS_GL + al256((size_t)MROWS * 1024 * 2);
constexpr size_t WS_QH = WS_AT + al256((size_t)MROWS * 2048 * 2);
constexpr size_t WS_KHT = WS_QH + al256((size_t)2 * MROWS * 512 * 2);
constexpr size_t WS_AM = WS_KHT + al256((size_t)2 * MROWS * 512 * 2);
constexpr size_t WS_VT = WS_AM + al256((size_t)2 * 272 * 8 * 32 * 32 * 2);
constexpr size_t WS_DEC = WS_VT + al256((size_t)272 * 8 * 128 * 32 * 2);
constexpr size_t WS_GO = WS_DEC + al256((size_t)2 * 272 * 512 * 4);
constexpr size_t WS_MACC = WS_GO + al256((size_t)2 * MROWS * 1024 * 4);
constexpr size_t WS_MRG = WS_MACC + al256((size_t)MROWS * DM * 4);
constexpr size_t WS_VN = WS_MRG + al256((size_t)MROWS * DM * 2);
constexpr size_t WS_ATG = WS_VN + al256((size_t)MROWS * 512 * 2);
constexpr size_t WS_ACAT = WS_ATG + al256((size_t)MROWS * 2048 * 2);
constexpr size_t WS_WCAT = WS_ACAT + al256((size_t)MROWS * DM * 2);
constexpr size_t WS_PART = WS_WCAT + al256((size_t)2 * DM * DM * 2);
constexpr size_t WS_UB = WS_PART + al256((size_t)8 * 512 * DM * 4);
constexpr size_t WS_PARTP = WS_UB + al256((size_t)MROWS * 1024 * 2);
constexpr size_t WS_END = WS_PARTP + al256((size_t)248 * 65536 * 4);

constexpr int CW_TMO = 0, CW_CODE = 1, CW_QUEUE = 1024, CW_PQ = 1536, CW_TQ = 2048, CW_BAR = 4096, CW_MQ = 131072  ;

constexpr int RING_OFF = 0, RING_BYTES = 147456;
constexpr int LDSCTL_OFF = RING_BYTES, MISC_OFF = LDSCTL_OFF + 320, INTAB_OFF = LDSCTL_OFF + 512;
constexpr int LDS_BYTES = 148480;

#define RLX_AGENT __ATOMIC_RELAXED, __HIP_MEMORY_SCOPE_AGENT
#define LDS_WAIT() asm volatile("s_waitcnt lgkmcnt(0)" ::: "memory")
#define VM_WAIT() asm volatile("s_waitcnt vmcnt(0)" ::: "memory")
__device__ __forceinline__ unsigned f2bf(float f) { unsigned u = __builtin_bit_cast(unsigned, f); return (u + 0x7fffu + ((u >> 16) & 1u)) >> 16; }
__device__ __forceinline__ unsigned pk2(float lo, float hi) { return f2bf(lo) | (f2bf(hi) << 16); }
__device__ __forceinline__ float bf2f(unsigned short b) { return __builtin_bit_cast(float, (unsigned)b << 16); }
__device__ __forceinline__ float bflo(unsigned w) { return __builtin_bit_cast(float, w << 16); }
__device__ __forceinline__ float bfhi(unsigned w) { return __builtin_bit_cast(float, w & 0xffff0000u); }
__device__ __forceinline__ float sigmoidf_(float x) { return __builtin_amdgcn_rcpf(1.0f + __builtin_amdgcn_exp2f(-1.4426950408889634f * x)); }
__device__ __forceinline__ float siluf_(float x) { return x * __builtin_amdgcn_rcpf(1.0f + __builtin_amdgcn_exp2f(-1.4426950408889634f * x)); }
__device__ __forceinline__ float gelu_tanh(float x) {
    const float u = 1.5957691216057308f * (x + 0.044715f * x * x * x); return x * __builtin_amdgcn_rcpf(1.0f + __builtin_amdgcn_exp2f(-1.4426950408889634f * u)); }
__device__ __forceinline__ float wave_sum(float v) {
#pragma unroll
    for (int o = 1; o < 64; o <<= 1) v += __shfl_xor(v, o);
    return v;
}
namespace pg8 {
#define PG8_LAS __attribute__((address_space(3)))
typedef unsigned short bf16_t;
typedef unsigned u32x4 __attribute__((ext_vector_type(4)));
constexpr int BM = 256, BK = 64, HALF = 128, HTB = HALF * BK * 2  , STAGE_BYTES = 8 * HTB, NXCD = 8, WGM = 8;

__host__ __device__ __forceinline__ int lds_byte(int r, int c) { const int st = (r >> 4) * 2 + (c >> 5), rr = r & 15, cc = c & 31, ob = rr * 64 + cc * 2; return st * 1024 + (ob ^ (((ob >> 9) & 1) << 5)); }
__host__ __device__ __forceinline__ void stage_rc(int b, int& R, int& C) { const int st = b / 1024, sb = b % 1024, swz = sb ^ (((sb >> 9) & 1) << 5); R = (st >> 1) * 16 + swz / 64; C = (st & 1) * 32 + (swz % 64) / 2; }
__host__ __device__ __forceinline__ int perm32(int rho) { const int n = rho >> 4, i = rho & 15; return 8 * (i >> 2) + 4 * n + (i & 3); }

struct Unit { int pm, pn, ko, aux; };
struct Gemm { const bf16_t* A; const bf16_t* Bt; int M, N, K, lda, ldb; };

struct StaticOrder {
    int nM, nN, nwg, G, c;
    __host__ __device__ void init(int M, int N, int G_, int c_) { nM = M / BM; nN = N / BM; nwg = nM * nN; G = G_; c = c_; }
    __host__ __device__ bool next(int i, Unit& u) const { return at((long)i * G + c, u); }
    __host__ __device__ bool at(long L, Unit& u) const {
        if (L >= nwg) return false;
        int wgid = (int)L; { const int q = nwg / NXCD, r = nwg % NXCD, xcd = wgid % NXCD, off = wgid / NXCD; wgid = (xcd < r ? xcd * (q + 1) : r * (q + 1) + (xcd - r) * q) + off; }
        const int nig = WGM * nN, gid = wgid / nig, fm = gid * WGM, gsz = (nM - fm) < WGM ? (nM - fm) : WGM;
        u.pm = fm + ((wgid % nig) % gsz); u.pn = (wgid % nig) / gsz; u.ko = 0; u.aux = 0; return true;
    }
    __device__ __forceinline__ void a_ready(const Unit&) const {}
    __device__ __forceinline__ void done(const Unit&) const {}
};

struct RowOrder {
    StaticOrder b; int lat;
    __host__ __device__ void init(int M, int N, int G_, int c_, int lat_) { lat = lat_; b.init(lat_ ? M - 512 : M, N, G_, c_); }
    __host__ __device__ bool next(int i, Unit& u) const { if (!b.next(i, u)) return false; if (lat) u.pm += 1 + (u.pm >= 16 ? 1 : 0); return true; }
    __device__ __forceinline__ void a_ready(const Unit&) const {}
    __device__ __forceinline__ void done(const Unit&) const {}
};

struct InProjOrder {
    StaticOrder b; int lat, G, c, imax;
    __host__ __device__ void init(int M, int N, int G_, int c_, int lat_, int imax_) { lat = lat_; G = G_; c = c_; imax = imax_; b.init(lat_ ? M - 512 : M, N, G_, c_); }
    __host__ __device__ bool next(int i, Unit& u) const { if (i >= imax) return false; return at((long)i * G + c, u); }
    __host__ __device__ bool at(long L, Unit& u) const {
        if (!lat) return b.at(L, u);
        if (b.at(L, u)) { u.pm += 1 + (u.pm >= 16 ? 1 : 0); return true; }
        const int e = (int)(L - b.nwg); if (e >= 30) return false;
        const int t = e % 15; u.pm = (e / 15) * 17; u.pn = t < 4 ? t : (t < 10 ? t + 6 : (t < 14 ? t + 18 : 88)); u.ko = 0; u.aux = 0; return true;
    }
    __device__ __forceinline__ void a_ready(const Unit&) const {}
    __device__ __forceinline__ void done(const Unit&) const {}
};

struct InProjSplitOrder {
    InProjOrder o; int G, c;
    __host__ __device__ void init(int M, int N, int G_, int c_) { G = G_; c = c_; o.init(M, N, G_, c_, 1, 1 << 30); }
    __host__ __device__ bool next(int i, Unit& u) const { const int s = i * G + c; if (s >= 248) return false; if (!o.at(2816 + (s >> 2), u)) return false; u.ko = (s & 3) * 1024; u.aux = s; return true; }
    __device__ __forceinline__ void a_ready(const Unit&) const {}
    __device__ __forceinline__ void done(const Unit&) const {}
};
struct EpiPartial {
    static constexpr bool KHOOK = false;
    static constexpr bool PERM = false, AFTER_DRAIN = false;
    float* PART;
    __device__ __forceinline__ void operator()(const f32x4 (&acc)[2][2][4][2], const Unit& u, int wr, int wc, int fr, int fq) const {
        float* dst = PART + (size_t)u.aux * 65536; const int rr0 = wr * 64 + fr, col0 = wc * 32 + 4 * fq;
#pragma unroll
        for (int ai = 0; ai < 2; ++ai)
#pragma unroll
            for (int m = 0; m < 4; ++m) { const int off = (rr0 + ai * HALF + m * 16) * 256 + col0;
#pragma unroll
                for (int bj = 0; bj < 2; ++bj)
#pragma unroll
                    for (int n = 0; n < 2; ++n) *(f32x4*)(dst + off + bj * HALF + n * 16) = acc[ai][bj][m][n]; }
    }
};

struct CtxSplitOrder {
    int G, c;
    __host__ __device__ void init(int G_, int c_) { G = G_; c = c_; }
    __host__ __device__ bool next(int i, Unit& u) const { const int L = i * G + c; if (L >= 256) return false; u.pm = (L >> 7) * 17; u.pn = (L >> 3) & 15; u.ko = (L & 7) * 512; u.aux = 0; return true; }
    __device__ __forceinline__ void a_ready(const Unit&) const {}
    __device__ __forceinline__ void done(const Unit&) const {}
};

__device__ __forceinline__ unsigned cvt_pk_bf16(float lo, float hi) { unsigned r; asm volatile("v_cvt_pk_bf16_f32 %0, %1, %2" : "=v"(r) : "v"(lo), "v"(hi)); return r; }
__device__ __forceinline__ u32x4 pack8(const f32x4 v0, const f32x4 v1) { u32x4 w; w.x = cvt_pk_bf16(v0[0], v0[1]); w.y = cvt_pk_bf16(v0[2], v0[3]); w.z = cvt_pk_bf16(v1[0], v1[1]); w.w = cvt_pk_bf16(v1[2], v1[3]); return w; }
__device__ __forceinline__ void unpack8(const u32x4 w, f32x4& v0, f32x4& v1) { v0 = (f32x4){bflo(w.x), bfhi(w.x), bflo(w.y), bfhi(w.y)}; v1 = (f32x4){bflo(w.z), bfhi(w.z), bflo(w.w), bfhi(w.w)}; }

struct EpiInProj {
    static constexpr bool KHOOK = false;
    static constexpr bool PERM = true, AFTER_DRAIN = false;
    bf16_t* P; bf16_t* UB;
    __device__ __forceinline__ void operator()(const f32x4 (&acc)[2][2][4][2], const Unit& u, int wr, int wc, int fr, int fq) const {
        const int pn = u.pn;
        const int act = (pn >= 40 && pn < 88) ? 2 : (((pn >= 4 && pn < 8) || (pn >= 16 && pn < 20) || (pn >= 32 && pn < 40)) ? 1 : 0);
        const int row0 = u.pm * BM + wr * 64 + fr, col0 = pn * BM + wc * 32 + 8 * fq;
#pragma unroll
        for (int ai = 0; ai < 2; ++ai)
#pragma unroll
            for (int m = 0; m < 4; ++m) { bf16_t* rowp = P + (size_t)(row0 + ai * HALF + m * 16) * NP + col0;
                if (pn < 4) {
                    const int bb = u.pm / 17, jj = (u.pm % 17) * BM + wr * 64 + fr + ai * HALF + m * 16;
#pragma unroll
                    for (int bj = 0; bj < 2; ++bj) { const int c = col0 + bj * HALF;
                        *(u32x4*)(UB + (((size_t)bb * 64 + (c >> 4)) * RPB + jj) * 16 + (c & 15)) = pack8(acc[ai][bj][m][0], acc[ai][bj][m][1]); }
                    continue; }
#pragma unroll
                for (int bj = 0; bj < 2; ++bj) { f32x4 v0 = acc[ai][bj][m][0], v1 = acc[ai][bj][m][1];
                    if (act == 1) {
#pragma unroll
                        for (int j = 0; j < 4; ++j) { v0[j] = siluf_(v0[j]); v1[j] = siluf_(v1[j]); } }
                    else if (act == 2) {
#pragma unroll
                        for (int j = 0; j < 4; ++j) { v0[j] = sigmoidf_(v0[j]); v1[j] = sigmoidf_(v1[j]); } }
                    *(u32x4*)(rowp + bj * HALF) = pack8(v0, v1); } }
    }
};
struct EpiGlu {
    static constexpr bool KHOOK = false;
    static constexpr bool PERM = true, AFTER_DRAIN = false;
    const bf16_t* GBp; const bf16_t* P; bf16_t* SBp;
    __device__ __forceinline__ void operator()(const f32x4 (&acc)[2][2][4][2], const Unit& u, int wr, int wc, int fr, int fq) const {
        const int row0 = u.pm * BM + wr * 64 + fr, col0 = u.pn * BM + wc * 32 + 8 * fq;
#pragma unroll
        for (int ai = 0; ai < 2; ++ai)
#pragma unroll
            for (int m = 0; m < 4; ++m) { const size_t row = (size_t)(row0 + ai * HALF + m * 16);
#pragma unroll
                for (int bj = 0; bj < 2; ++bj) { const int col = col0 + bj * HALF;
                    f32x4 g0, g1, z0, z1; unpack8(*(const u32x4*)(GBp + row * 1024 + col), g0, g1); unpack8(*(const u32x4*)(P + row * NP + C_SZ + col), z0, z1);
                    f32x4 v0 = acc[ai][bj][m][0], v1 = acc[ai][bj][m][1];
#pragma unroll
                    for (int j = 0; j < 4; ++j) { v0[j] = g0[j] * sigmoidf_(v0[j]) * z0[j]; v1[j] = g1[j] * sigmoidf_(v1[j]) * z1[j]; }
                    *(u32x4*)(SBp + row * DM + col) = pack8(v0, v1); } }
    }
};
struct EpiProjCat {
    static constexpr bool KHOOK = true;
    static constexpr bool PERM = true, AFTER_DRAIN = false;
    const bf16_t* P; bf16_t* MRG;
    __device__ __forceinline__ void khook(f32x4 (&acc)[2][2][4][2], const Unit& u, int t, int wr, int wc, int fr, int fq) const {
        const int gn = C_MG + (t == 16 ? 0 : 4096);
        int fr_ = fr, fq_ = fq; asm volatile("" : "+v"(fr_), "+v"(fq_));
        const int row0 = u.pm * BM + wr * 64 + fr_, col0 = u.pn * BM + wc * 32 + 8 * fq_;
#pragma unroll
        for (int ai = 0; ai < 2; ++ai)
#pragma unroll
            for (int mp = 0; mp < 2; ++mp) {
                u32x4 gnum[2][2], gden[2][2];
#pragma unroll
                for (int mm = 0; mm < 2; ++mm)
#pragma unroll
                    for (int bj = 0; bj < 2; ++bj) { const bf16_t* gp = P + (size_t)(row0 + ai * HALF + (2 * mp + mm) * 16) * NP + gn + col0 + bj * HALF; gnum[mm][bj] = *(const u32x4*)gp; gden[mm][bj] = *(const u32x4*)(gp + 4096); }
#pragma unroll
                for (int mm = 0; mm < 2; ++mm)
#pragma unroll
                    for (int bj = 0; bj < 2; ++bj) { const int m = 2 * mp + mm; f32x4 n0, n1, d0, d1; unpack8(gnum[mm][bj], n0, n1); unpack8(gden[mm][bj], d0, d1);
#pragma unroll
                        for (int j = 0; j < 4; ++j) { acc[ai][bj][m][0][j] *= n0[j] * __builtin_amdgcn_rcpf(d0[j]); acc[ai][bj][m][1][j] *= n1[j] * __builtin_amdgcn_rcpf(d1[j]); } }
                asm volatile("" ::: "memory");
            }
    }
    __device__ __forceinline__ void operator()(const f32x4 (&acc)[2][2][4][2], const Unit& u, int wr, int wc, int fr, int fq) const {
        const int row0 = u.pm * BM + wr * 64 + fr, col0 = u.pn * BM + wc * 32 + 8 * fq;
#pragma unroll
        for (int ai = 0; ai < 2; ++ai)
#pragma unroll
            for (int m = 0; m < 4; ++m) { const size_t row = (size_t)(row0 + ai * HALF + m * 16);
#pragma unroll
                for (int bj = 0; bj < 2; ++bj) { const int col = col0 + bj * HALF;
                    f32x4 g0, g1; unpack8(*(const u32x4*)(P + row * NP + C_MG + 8192 + col), g0, g1);
                    *(u32x4*)(MRG + row * DM + col) = pack8(acc[ai][bj][m][0] * g0, acc[ai][bj][m][1] * g1); } }
    }
};
struct EpiOut {
    static constexpr bool KHOOK = false;
    static constexpr bool PERM = false, AFTER_DRAIN = false;
    const float* xin; const float* cin; float* X1; float* out; const float* MODl; int layer;
    __device__ __forceinline__ void operator()(const f32x4 (&acc)[2][2][4][2], const Unit& u, int wr, int wc, int fr, int fq) const {
        const int b = u.pm / 17, jt = u.pm % 17; const bool isctx = (jt == 0);
        if (layer == 1 && isctx) return;
        const float* src; float* dst;
        if (layer == 0) { src = isctx ? cin + (size_t)b * TC * DM : xin + ((size_t)b * TL + (size_t)(jt - 1) * 256) * DM; dst = X1 + (size_t)u.pm * 256 * DM; }
        else { src = X1 + (size_t)u.pm * 256 * DM; dst = out + ((size_t)b * TL + (size_t)(jt - 1) * 256) * DM; }
        const float* gv = MODl + (size_t)(isctx ? 2 : b) * 12288 + 8192;
        const int rr0 = wr * 64 + fr, col0 = u.pn * BM + wc * 32 + 4 * fq;
        f32x4 gt[2][2];
#pragma unroll
        for (int bj = 0; bj < 2; ++bj)
#pragma unroll
            for (int n = 0; n < 2; ++n) gt[bj][n] = *(const f32x4*)(gv + col0 + bj * HALF + n * 16);
#pragma unroll
        for (int ai = 0; ai < 2; ++ai)
#pragma unroll
            for (int m = 0; m < 4; ++m) { const size_t off = (size_t)(rr0 + ai * HALF + m * 16) * DM + col0;
#pragma unroll
                for (int bj = 0; bj < 2; ++bj)
#pragma unroll
                    for (int n = 0; n < 2; ++n) { const f32x4 xo = *(const f32x4*)(src + off + bj * HALF + n * 16);
                        *(f32x4*)(dst + off + bj * HALF + n * 16) = xo + gt[bj][n] * acc[ai][bj][m][n]; } }
    }
};


struct EpiOutCtxPartial {
    static constexpr bool KHOOK = false;
    static constexpr bool PERM = false, AFTER_DRAIN = false;
    float* PART;
    __device__ __forceinline__ void operator()(const f32x4 (&acc)[2][2][4][2], const Unit& u, int wr, int wc, int fr, int fq) const {
        float* dst = PART + ((size_t)(u.ko >> 9) * 512 + (size_t)(u.pm / 17) * 256) * DM;
        const int rr0 = wr * 64 + fr, col0 = u.pn * BM + wc * 32 + 4 * fq;
#pragma unroll
        for (int ai = 0; ai < 2; ++ai)
#pragma unroll
            for (int m = 0; m < 4; ++m) { const size_t off = (size_t)(rr0 + ai * HALF + m * 16) * DM + col0;
#pragma unroll
                for (int bj = 0; bj < 2; ++bj)
#pragma unroll
                    for (int n = 0; n < 2; ++n) *(f32x4*)(dst + off + bj * HALF + n * 16) = acc[ai][bj][m][n]; }
    }
};
template <class Epi, class Sched, bool ALIGN_EPI = false, bool SP2 = false>
__device__ __forceinline__ void gemm_phase(PG8_LAS unsigned char* lds, const Gemm g, const Sched& S, const Epi& E, const int tid_in) {
    const int tid = tid_in  , wid = __builtin_amdgcn_readfirstlane(tid >> 6), lane = tid & 63, wr = wid >> 2, wc = wid & 3, fr = lane & 15, fq = lane >> 4;
    const int K = g.K, nt = K / BK;
    unsigned voffA[2], voffB[2];
#pragma unroll
    for (int i = 0; i < 2; ++i) { int R, C; stage_rc(tid * 16 + i * 8192, R, C); const int Rb = Epi::PERM ? ((R & ~31) + perm32(R & 31)) : R;
        voffA[i] = (unsigned)(R * g.lda + C) * 2u; voffB[i] = (unsigned)(Rb * g.ldb + C) * 2u; }
    const size_t kstep = (size_t)(BK * 2);
    const size_t hstepA = (size_t)HALF * g.lda * 2, hstepB = (size_t)HALF * g.ldb * 2;
    const size_t tstepA = 2 * hstepA, tstepB = 2 * hstepB;
    const unsigned ldsw = (unsigned)wid * 1024u;
    const int aoff = lds_byte(wr * 64 + fr, fq * 8), boff = lds_byte(wc * 32 + fr, fq * 8);
#define PG8_SA(b, h) (((b) * 2 + (h)) * HTB)
#define PG8_SB(b, h) ((4 + (b) * 2 + (h)) * HTB)
#define PG8_STAGE(bufoff, gbase, voff) do { _Pragma("unroll") for (int _i = 0; _i < 2; ++_i) \
        __builtin_amdgcn_global_load_lds((const unsigned*)((const char*)(gbase) + (voff)[_i]), (PG8_LAS unsigned*)(lds + (bufoff) + ldsw + _i * 8192), 16, 0, 0); } while (0)
#define PG8_LDA(dst, b, h) do { _Pragma("unroll") for (int m = 0; m < 4; ++m) _Pragma("unroll") for (int k = 0; k < 2; ++k) dst[m][k] = *(const PG8_LAS bf16x8*)(lds + PG8_SA(b, h) + aoff + m * 2048 + k * 1024); } while (0)
#define PG8_LDB(dst, b, h) do { _Pragma("unroll") for (int n = 0; n < 2; ++n) _Pragma("unroll") for (int k = 0; k < 2; ++k) dst[n][k] = *(const PG8_LAS bf16x8*)(lds + PG8_SB(b, h) + boff + n * 2048 + k * 1024); } while (0)
#define PG8_MMA(ai, bj, At, Bt) do { __builtin_amdgcn_s_setprio(1); _Pragma("unroll") for (int m = 0; m < 4; ++m) _Pragma("unroll") for (int n = 0; n < 2; ++n) _Pragma("unroll") for (int k = 0; k < 2; ++k) \
        acc[ai][bj][m][n] = __builtin_amdgcn_mfma_f32_16x16x32_bf16(Bt[n][k], At[m][k], acc[ai][bj][m][n], 0, 0, 0); __builtin_amdgcn_s_setprio(0); } while (0)
#define PG8_WAIT_V(n) asm volatile("s_waitcnt vmcnt(" #n ")" ::: "memory")
#define PG8_WAIT_L(n) asm volatile("s_waitcnt lgkmcnt(" #n ")" ::: "memory")
#define PG8_BAR __builtin_amdgcn_s_barrier()
#define PG8_SCHED __builtin_amdgcn_sched_barrier(0)
    Unit cur, nxt; int ui = 0;
    if (!S.next(0, cur)) return;
    f32x4 acc[2][2][4][2];
#pragma unroll
    for (int a = 0; a < 2; ++a)
#pragma unroll
        for (int b = 0; b < 2; ++b)
#pragma unroll
            for (int m = 0; m < 4; ++m)
#pragma unroll
                for (int n = 0; n < 2; ++n) acc[a][b][m][n] = (f32x4){0.f, 0.f, 0.f, 0.f};
    bf16x8 At[4][2], B0[2][2], B1[2][2];
    const char* cA = (const char*)g.A + (size_t)cur.pm * tstepA + (size_t)cur.ko * 2; const char* cB = (const char*)g.Bt + (size_t)cur.pn * tstepB + (size_t)cur.ko * 2;
    S.a_ready(cur);
    if constexpr (SP2) {
        PG8_STAGE(PG8_SB(0, 0), cB, voffB); PG8_STAGE(PG8_SB(0, 1), cB + hstepB, voffB); PG8_STAGE(PG8_SA(0, 0), cA, voffA); PG8_STAGE(PG8_SA(0, 1), cA + hstepA, voffA);
        if (wr == 1) PG8_BAR;
        PG8_WAIT_V(2); PG8_BAR;
        PG8_STAGE(PG8_SB(1, 0), cB + kstep, voffB); PG8_STAGE(PG8_SA(1, 0), cA + kstep, voffA); PG8_STAGE(PG8_SB(1, 1), cB + hstepB + kstep, voffB);
        PG8_WAIT_V(6); PG8_BAR;
    } else {
        PG8_STAGE(PG8_SB(0, 0), cB, voffB); PG8_STAGE(PG8_SA(0, 0), cA, voffA); PG8_STAGE(PG8_SB(0, 1), cB + hstepB, voffB); PG8_STAGE(PG8_SA(0, 1), cA + hstepA, voffA);
        if (wr == 1) PG8_BAR;
        PG8_WAIT_V(4); PG8_BAR;
        PG8_STAGE(PG8_SB(1, 0), cB + kstep, voffB); PG8_STAGE(PG8_SA(1, 0), cA + kstep, voffA); PG8_STAGE(PG8_SB(1, 1), cB + hstepB + kstep, voffB);
        PG8_WAIT_V(6); PG8_BAR;
    }
    for (;;) {
        const bool has_next = S.next(ui + 1, nxt);
        const char* nA = has_next ? (const char*)g.A + (size_t)nxt.pm * tstepA + (size_t)nxt.ko * 2 : cA; const char* nB = has_next ? (const char*)g.Bt + (size_t)nxt.pn * tstepB + (size_t)nxt.ko * 2 : cB;
        for (int t = 0; t < nt; t += 2) {
            const bool last = (t == nt - 2);
            const char* a1 = cA + (size_t)(t + 1) * kstep;
            const char* a2 = last ? nA : cA + (size_t)(t + 2) * kstep; const char* b2 = last ? nB : cB + (size_t)(t + 2) * kstep;
            const char* a3 = a2 + kstep; const char* b3 = b2 + kstep;
            if (last && has_next) S.a_ready(nxt);
            if constexpr (Epi::KHOOK) { if (t == 16 || t == 32) E.khook(acc, cur, t, wr, wc, fr, fq); }
            if constexpr (SP2) {
            PG8_LDB(B0, 0, 0); PG8_LDB(B1, 0, 1); PG8_SCHED; PG8_LDA(At, 0, 0); PG8_STAGE(PG8_SA(1, 1), a1 + hstepA, voffA);
            PG8_WAIT_V(8); PG8_WAIT_L(0); PG8_BAR; PG8_MMA(0, 0, At, B0); PG8_MMA(0, 1, At, B1); PG8_BAR; PG8_SCHED;
            PG8_LDA(At, 0, 1); PG8_STAGE(PG8_SB(0, 0), b2, voffB); PG8_STAGE(PG8_SB(0, 1), b2 + hstepB, voffB); PG8_STAGE(PG8_SA(0, 0), a2, voffA);
            PG8_WAIT_V(8); PG8_WAIT_L(0); PG8_BAR; PG8_MMA(1, 0, At, B0); PG8_MMA(1, 1, At, B1); PG8_BAR; PG8_SCHED;
            PG8_LDB(B0, 1, 0); PG8_LDB(B1, 1, 1); PG8_SCHED; PG8_LDA(At, 1, 0); PG8_STAGE(PG8_SA(0, 1), a2 + hstepA, voffA);
            PG8_WAIT_V(8); PG8_WAIT_L(0); PG8_BAR; PG8_MMA(0, 0, At, B0); PG8_MMA(0, 1, At, B1); PG8_BAR; PG8_SCHED;
            PG8_LDA(At, 1, 1); PG8_STAGE(PG8_SB(1, 0), b3, voffB); PG8_STAGE(PG8_SB(1, 1), b3 + hstepB, voffB); PG8_STAGE(PG8_SA(1, 0), a3, voffA);
            PG8_WAIT_V(8); PG8_WAIT_L(0); PG8_BAR; PG8_MMA(1, 0, At, B0); PG8_MMA(1, 1, At, B1); PG8_BAR; PG8_SCHED;
            } else {
            PG8_LDB(B0, 0, 0); PG8_SCHED; PG8_LDA(At, 0, 0); PG8_STAGE(PG8_SA(1, 1), a1 + hstepA, voffA);
            PG8_WAIT_L(8); PG8_BAR; PG8_WAIT_L(0); PG8_MMA(0, 0, At, B0); PG8_BAR; PG8_SCHED;
            PG8_LDB(B1, 0, 1); PG8_STAGE(PG8_SB(0, 0), b2, voffB);
            PG8_BAR; PG8_WAIT_L(0); PG8_MMA(0, 1, At, B1); PG8_BAR;
            PG8_LDA(At, 0, 1); PG8_STAGE(PG8_SA(0, 0), a2, voffA);
            PG8_BAR; PG8_WAIT_L(0); PG8_MMA(1, 0, At, B0); PG8_BAR; PG8_SCHED;
            PG8_STAGE(PG8_SB(0, 1), b2 + hstepB, voffB);
            PG8_WAIT_V(6); PG8_BAR; PG8_MMA(1, 1, At, B1); PG8_BAR;
            PG8_LDB(B0, 1, 0); PG8_SCHED; PG8_LDA(At, 1, 0); PG8_STAGE(PG8_SA(0, 1), a2 + hstepA, voffA);
            PG8_WAIT_L(8); PG8_BAR; PG8_WAIT_L(0); PG8_MMA(0, 0, At, B0); PG8_BAR; PG8_SCHED;
            PG8_LDB(B1, 1, 1); PG8_STAGE(PG8_SB(1, 0), b3, voffB);
            PG8_BAR; PG8_WAIT_L(0); PG8_MMA(0, 1, At, B1); PG8_BAR;
            PG8_LDA(At, 1, 1); PG8_STAGE(PG8_SA(1, 0), a3, voffA);
            PG8_BAR; PG8_WAIT_L(0); PG8_MMA(1, 0, At, B0); PG8_BAR; PG8_SCHED;
            PG8_STAGE(PG8_SB(1, 1), b3 + hstepB, voffB);
            PG8_WAIT_V(6); PG8_BAR; PG8_MMA(1, 1, At, B1); PG8_BAR;
            }
        }
        if constexpr (ALIGN_EPI) { if (wr == 0) PG8_BAR; }
        if constexpr (!Epi::AFTER_DRAIN) { E(acc, cur, wr, wc, fr, fq); S.done(cur); }
        if (!has_next) break;
#pragma unroll
        for (int a = 0; a < 2; ++a)
#pragma unroll
            for (int b = 0; b < 2; ++b)
#pragma unroll
                for (int m = 0; m < 4; ++m)
#pragma unroll
                    for (int n = 0; n < 2; ++n) acc[a][b][m][n] = (f32x4){0.f, 0.f, 0.f, 0.f};
        cur = nxt; cA = nA; cB = nB; ++ui;
        if constexpr (ALIGN_EPI) { if (wr == 1) PG8_BAR; }
    }
    PG8_WAIT_V(0);
    if constexpr (!ALIGN_EPI) { if (wr == 0) PG8_BAR; }
    PG8_BAR;
    if constexpr (Epi::AFTER_DRAIN) { E.fused(acc, cur, wr, wc, fr, fq, lds, wid, lane); S.done(cur); }
#undef PG8_SA
#undef PG8_SB
#undef PG8_STAGE
#undef PG8_LDA
#undef PG8_LDB
#undef PG8_MMA
#undef PG8_WAIT_V
#undef PG8_WAIT_L
#undef PG8_BAR
#undef PG8_SCHED
}
}
namespace att {
using bf16 = __hip_bfloat16;
constexpr int D = 128, NW = 8, QBLK = 32, KVBLK = 64;
constexpr float SCALE = 0.088388347648318440f;
constexpr float THR = 8.f;
constexpr int SDEPTH = 2;
constexpr int LDQ = 2048, LDK = 512, LDV = 512, LDO = 2048;
constexpr size_t SHM_V = KVBLK * D * 2, SHM_K = KVBLK * D * 2, SHM_ATTN = 2 * SHM_V + 2 * SHM_K + NW * 64 * 4;
using bf16x8 = __attribute__((ext_vector_type(8))) short;
using s16x4  = __attribute__((ext_vector_type(4))) short;
using f32x16 = __attribute__((ext_vector_type(16))) float;
using f32x8  = __attribute__((ext_vector_type(8))) float;
using u32x4  = __attribute__((ext_vector_type(4))) unsigned;
#define KSWZ(row, colB) ((row) * 256 + ((colB) ^ (((row) & 7) << 4)))
#define SBAR() __builtin_amdgcn_sched_barrier(0)
__device__ __forceinline__ int crow(int r, int hi) { return (r & 3) + 8 * (r >> 2) + 4 * hi; }
__device__ __forceinline__ unsigned cvtpk(float lo, float hi) {
  unsigned r; asm volatile("v_cvt_pk_bf16_f32 %0, %1, %2" : "=v"(r) : "v"(lo), "v"(hi)); return r;
}
template <typename TIn> struct Stage;
template <> struct Stage<bf16>  { using T = bf16x8;
  __device__ static __forceinline__ T ld8(const bf16* p) { return *reinterpret_cast<const bf16x8*>(p); }
  __device__ static __forceinline__ bf16x8 tobf(T x) { return x; } };
__device__ __forceinline__ void partialSM(f32x16& p0, f32x16& p1, float& m_reg, float& mn, float& alpha) {
  constexpr float C = SCALE * 1.4426950408889634f;
  float pmax = p0[0]; for (int r = 1; r < 16; ++r) pmax = fmaxf(pmax, p0[r]); for (int r = 0; r < 16; ++r) pmax = fmaxf(pmax, p1[r]);
  { auto rr = __builtin_amdgcn_permlane32_swap(__float_as_uint(pmax), __float_as_uint(pmax), false, false);
    pmax = fmaxf(__uint_as_float(rr[0]), __uint_as_float(rr[1])); }
  if (__builtin_expect(__all(pmax - m_reg <= THR / SCALE), 1)) { mn = m_reg; alpha = 1.f; }
  else { mn = fmaxf(m_reg, pmax); alpha = __builtin_amdgcn_exp2f((m_reg - mn) * C); m_reg = mn; }
  float mnC = -mn * C;
  for (int r = 0; r < 16; ++r) p0[r] = fmaf(p0[r], C, mnC); for (int r = 0; r < 16; ++r) p1[r] = fmaf(p1[r], C, mnC);
  for (int r = 0; r < 16; ++r) p0[r] = __builtin_amdgcn_exp2f(p0[r]);
}
__device__ __forceinline__ void finishSM(f32x16& p0, f32x16& p1, float alpha, float& l_reg, bf16x8& pa0, bf16x8& pa1, bf16x8& pa2, bf16x8& pa3) {
  for (int r = 0; r < 16; ++r) p1[r] = __builtin_amdgcn_exp2f(p1[r]);
  float ps = 0; for (int r = 0; r < 16; ++r) ps += p0[r]; for (int r = 0; r < 16; ++r) ps += p1[r];
  { auto rr = __builtin_amdgcn_permlane32_swap(__float_as_uint(ps), __float_as_uint(ps), false, false);
    ps = __uint_as_float(rr[0]) + __uint_as_float(rr[1]); }
  l_reg = l_reg * alpha + ps;
#define PK4(P, BASE, OUT) do { unsigned a0 = cvtpk(P[BASE + 0], P[BASE + 1]), a1 = cvtpk(P[BASE + 2], P[BASE + 3]);   \
    unsigned b0 = cvtpk(P[BASE + 4], P[BASE + 5]), b1 = cvtpk(P[BASE + 6], P[BASE + 7]);                              \
    auto r0 = __builtin_amdgcn_permlane32_swap(a0, b0, false, false); auto r1 = __builtin_amdgcn_permlane32_swap(a1, b1, false, false); \
    u32x4 w = {r0[0], r1[0], r0[1], r1[1]}; OUT = *reinterpret_cast<bf16x8*>(&w); } while (0)
  PK4(p0, 0, pa0); PK4(p0, 8, pa1); PK4(p1, 0, pa2); PK4(p1, 8, pa3);
#undef PK4
}
__device__ __forceinline__ void qkt(f32x16& p0, f32x16& p1, const bf16* Ks, const bf16x8* qr, int r32, int hi) {
  p0 = f32x16{}; p1 = f32x16{};
  for (int d0 = 0; d0 < 8; ++d0) { int cb = (d0 * 16 + hi * 8) * 2;
    bf16x8 b0 = *reinterpret_cast<const bf16x8*>((const char*)Ks + KSWZ(r32, cb));
    bf16x8 b1 = *reinterpret_cast<const bf16x8*>((const char*)Ks + KSWZ(32 + r32, cb));
    p0 = __builtin_amdgcn_mfma_f32_32x32x16_bf16(b0, qr[d0], p0, 0, 0, 0);
    p1 = __builtin_amdgcn_mfma_f32_32x32x16_bf16(b1, qr[d0], p1, 0, 0, 0); }
}
__device__ __forceinline__ int v_st(int k, int c) { const int kk = (k & ~0xC) | ((k & 4) << 1) | ((k & 8) >> 1); return ((kk >> 3) * 4 + (c >> 5)) * 512 + ((kk & 7) * 32 + (c & 31)) * 2; }
__device__ __forceinline__ int v_rd_base(int lane) { return ((lane & 3) << 3) | (((lane >> 2) & 3) << 6) | (((lane >> 4) & 1) << 5) | (((lane >> 5) & 1) << 8); }
constexpr int v_rd_off(int d0, int ks, int half) { return d0 * 512 + ks * 4096 + half * 2048; }
template <int OFF> __device__ __forceinline__ s16x4 tr_read(int vb) {
  s16x4 r; asm volatile("ds_read_b64_tr_b16 %0, %1 offset:%2" : "=&v"(r) : "v"(vb), "i"(OFF) : "memory"); return r;
}
template <int D0> __device__ __forceinline__ void pv_one(f32x16& od, int vb, bf16x8 pa0, bf16x8 pa1, bf16x8 pa2, bf16x8 pa3) {
  const s16x4 l0 = tr_read<v_rd_off(D0, 0, 0)>(vb), h0 = tr_read<v_rd_off(D0, 0, 1)>(vb), l1 = tr_read<v_rd_off(D0, 1, 0)>(vb), h1 = tr_read<v_rd_off(D0, 1, 1)>(vb);
  const s16x4 l2 = tr_read<v_rd_off(D0, 2, 0)>(vb), h2 = tr_read<v_rd_off(D0, 2, 1)>(vb), l3 = tr_read<v_rd_off(D0, 3, 0)>(vb), h3 = tr_read<v_rd_off(D0, 3, 1)>(vb);
  asm volatile("s_waitcnt lgkmcnt(0)" ::: "memory"); SBAR();
#define PK(L, H) (bf16x8){L[0], L[1], L[2], L[3], H[0], H[1], H[2], H[3]}
  od = __builtin_amdgcn_mfma_f32_32x32x16_bf16(pa0, PK(l0, h0), od, 0, 0, 0);
  od = __builtin_amdgcn_mfma_f32_32x32x16_bf16(pa1, PK(l1, h1), od, 0, 0, 0);
  od = __builtin_amdgcn_mfma_f32_32x32x16_bf16(pa2, PK(l2, h2), od, 0, 0, 0);
  od = __builtin_amdgcn_mfma_f32_32x32x16_bf16(pa3, PK(l3, h3), od, 0, 0, 0);
#undef PK
}
__device__ __forceinline__ void pv_d0(f32x16* o, int vb, bf16x8 pa0, bf16x8 pa1, bf16x8 pa2, bf16x8 pa3) {
  pv_one<0>(o[0], vb, pa0, pa1, pa2, pa3); pv_one<1>(o[1], vb, pa0, pa1, pa2, pa3); pv_one<2>(o[2], vb, pa0, pa1, pa2, pa3); pv_one<3>(o[3], vb, pa0, pa1, pa2, pa3);
}

template <typename TQ>
__device__ __forceinline__ void attn_dense_body(const TQ* __restrict__ Qb, const bf16* __restrict__ Kh, const bf16* __restrict__ Vh,
                                                unsigned short* __restrict__ Ob, int seq, char* lds, const int tid_in,
                                                const int ldq, const float* __restrict__ gq, const float* __restrict__ rope, const int tpos0  ) {
  using St = Stage<bf16>; using SQ = Stage<TQ>;
  const int tid = tid_in  , wid = tid >> 6, lane = tid & 63, r32 = lane & 31, hi = lane >> 5;
  bf16* V_lds = (bf16*)lds; bf16* K_lds = (bf16*)(lds + 2 * SHM_V);
  float* ws = (float*)(lds + 2 * SHM_V + 2 * SHM_K) + wid * 64; float* li_l = ws; float* al_l = ws + 32;
  float m_reg = -1e30f, l_reg = 0; f32x16 o[4] = {}; bf16x8 qr[8];
  const TQ* Qw = Qb + (long)(wid * QBLK + r32) * ldq + hi * 8;
#pragma unroll
  for (int d0 = 0; d0 < 8; ++d0) qr[d0] = SQ::tobf(SQ::ld8(Qw + d0 * 16));
  {
    float x[8][8]; float ss = 0.f;
#pragma unroll
    for (int d0 = 0; d0 < 8; ++d0)
#pragma unroll
      for (int j = 0; j < 8; ++j) { x[d0][j] = __builtin_bit_cast(float, (unsigned)(unsigned short)qr[d0][j] << 16); ss += x[d0][j] * x[d0][j]; }
    ss += __shfl_xor(ss, 32);
    const float rstd = 1.0f / sqrtf(ss * (1.0f / 128.0f) + 1e-6f);
#pragma unroll
    for (int d0 = 0; d0 < 8; ++d0) { const f32x8 g8 = *reinterpret_cast<const f32x8*>(gq + d0 * 16 + hi * 8);
#pragma unroll
      for (int j = 0; j < 8; ++j) x[d0][j] *= rstd * g8[j]; }
    if (tpos0 >= 0) { const int t = tpos0 + wid * QBLK + r32;
#pragma unroll
      for (int ax = 0; ax < 2; ++ax) { const int pos = ax ? (t & 63) : (t >> 6);
#pragma unroll
        for (int e = 0; e < 2; ++e) {
          const f32x8 c8 = *reinterpret_cast<const f32x8*>(rope + pos * 32 + 16 * e + 8 * hi), s8 = *reinterpret_cast<const f32x8*>(rope + 2048 + pos * 32 + 16 * e + 8 * hi);
#pragma unroll
          for (int j = 0; j < 8; ++j) { const float lo = x[4 * ax + e][j], hh = x[4 * ax + e + 2][j];
            x[4 * ax + e][j] = lo * c8[j] - hh * s8[j]; x[4 * ax + e + 2][j] = hh * c8[j] + lo * s8[j]; } } } }
#pragma unroll
    for (int d0 = 0; d0 < 8; ++d0) { u32x4 w = {cvtpk(x[d0][0], x[d0][1]), cvtpk(x[d0][2], x[d0][3]), cvtpk(x[d0][4], x[d0][5]), cvtpk(x[d0][6], x[d0][7])}; qr[d0] = *reinterpret_cast<bf16x8*>(&w); }
  }
  const int sr = tid >> 4, sc = (tid & 15) * 8, vst0 = v_st(sr, sc), vst1 = v_st(32 + sr, sc);
  const int vb0 = (int)(uintptr_t)V_lds + v_rd_base(lane);
  struct { typename St::T vs0, vs1, ks0, ks1; } sr_[SDEPTH];
#define SLOAD(i, k0) do { sr_[i].vs0 = St::ld8(&Vh[(long)((k0) + sr) * LDV + sc]); sr_[i].vs1 = St::ld8(&Vh[(long)((k0) + 32 + sr) * LDV + sc]); \
    sr_[i].ks0 = St::ld8(&Kh[(long)((k0) + sr) * LDK + sc]); sr_[i].ks1 = St::ld8(&Kh[(long)((k0) + 32 + sr) * LDK + sc]); } while (0)
#define SWRITE(b, i) do { *(bf16x8*)((char*)V_lds + (b) * SHM_V + vst0) = St::tobf(sr_[i].vs0);          \
    *(bf16x8*)((char*)V_lds + (b) * SHM_V + vst1) = St::tobf(sr_[i].vs1); int kc = sc * 2;               \
    *(bf16x8*)((char*)K_lds + (b) * SHM_K + KSWZ(sr, kc)) = St::tobf(sr_[i].ks0);                       \
    *(bf16x8*)((char*)K_lds + (b) * SHM_K + KSWZ(32 + sr, kc)) = St::tobf(sr_[i].ks1); } while (0)
#define SWAIT() do { if constexpr (SDEPTH == 2) asm volatile("s_waitcnt vmcnt(4)" ::: "memory"); else asm volatile("s_waitcnt vmcnt(0)" ::: "memory"); } while (0)
#define RESC(a) do { if (__any((a) < 1.f)) { if (hi == 0) al_l[r32] = (a); asm volatile("s_waitcnt lgkmcnt(0)" ::: "memory"); \
    for (int d = 0; d < 4; ++d) for (int r = 0; r < 16; ++r) o[d][r] *= al_l[crow(r, hi)]; } } while (0)
  f32x16 pA0, pA1, pB0, pB1; float mnA, mnB, alA, alB; bf16x8 pa0, pa1, pa2, pa3; const int NT = seq / KVBLK;
  constexpr int SE = 0, SO = SDEPTH - 1;
  SLOAD(SE, 0); asm volatile("s_waitcnt vmcnt(0)" ::: "memory"); SWRITE(0, SE); __syncthreads();
  qkt(pA0, pA1, K_lds, qr, r32, hi); partialSM(pA0, pA1, m_reg, mnA, alA);
  SLOAD(SO, KVBLK); if constexpr (SDEPTH == 2) { if (2 < NT) SLOAD(SE, 2 * KVBLK); }
  SWAIT(); SWRITE(1, SO); __syncthreads();
  for (int j = 1; j + 1 < NT; j += 2) {
    SBAR(); qkt(pB0, pB1, (bf16*)((char*)K_lds + SHM_K), qr, r32, hi);
    finishSM(pA0, pA1, alA, l_reg, pa0, pa1, pa2, pa3); SBAR();
    SLOAD(SO, (j + SDEPTH) * KVBLK); SBAR();
    pv_d0(o, vb0, pa0, pa1, pa2, pa3); partialSM(pB0, pB1, m_reg, mnB, alB);
    __syncthreads(); SWAIT(); SWRITE(0, SE);
    RESC(alB); __syncthreads();
    SBAR(); qkt(pA0, pA1, K_lds, qr, r32, hi);
    finishSM(pB0, pB1, alB, l_reg, pa0, pa1, pa2, pa3); SBAR();
    if (SDEPTH == 1 || j + 3 < NT) SLOAD(SE, (j + 1 + SDEPTH) * KVBLK); SBAR();
    pv_d0(o, vb0 + (int)SHM_V, pa0, pa1, pa2, pa3); partialSM(pA0, pA1, m_reg, mnA, alA);
    __syncthreads(); SWAIT(); SWRITE(1, SO);
    RESC(alA); __syncthreads();
  }
  SBAR(); qkt(pB0, pB1, (bf16*)((char*)K_lds + SHM_K), qr, r32, hi);
  finishSM(pA0, pA1, alA, l_reg, pa0, pa1, pa2, pa3); SBAR();
  pv_d0(o, vb0, pa0, pa1, pa2, pa3); partialSM(pB0, pB1, m_reg, mnB, alB);
  __syncthreads(); RESC(alB);
  finishSM(pB0, pB1, alB, l_reg, pa0, pa1, pa2, pa3); SBAR();
  pv_d0(o, vb0 + (int)SHM_V, pa0, pa1, pa2, pa3);
  if (hi == 0) li_l[r32] = l_reg; asm volatile("s_waitcnt lgkmcnt(0)" ::: "memory");
  float rli[16];
#pragma unroll
  for (int r = 0; r < 16; ++r) rli[r] = __builtin_amdgcn_rcpf(li_l[crow(r, hi)]);
  unsigned short* Ow = Ob + (long)(wid * QBLK) * LDO;
#pragma unroll
  for (int r = 0; r < 16; ++r) { int orow = crow(r, hi);
    for (int d0 = 0; d0 < 4; ++d0) Ow[(long)orow * LDO + d0 * 32 + r32] = (unsigned short)f2bf(o[d0][r] * rli[r]); }
  __syncthreads();
#undef SLOAD
#undef SWRITE
#undef SWAIT
#undef RESC
}
#undef KSWZ
#undef SBAR
}

#define XB_TMO      128
#define XB_XCNT(j)  (256  + 64 * (j))
#define XB_XSUB(j)  (1280 + 64 * (j))
#define XB_XGEN(j)  (2304 + 64 * (j))
#define XB_TOP      3328
#define XB_TOPGEN   3392
#define XCD_BAR_WORDS 3456
#define XB_SPIN_CAP (1u << 18)

__device__ __forceinline__ unsigned xb_ld(unsigned* p)              { return __hip_atomic_load(p, __ATOMIC_RELAXED, __HIP_MEMORY_SCOPE_AGENT); }
__device__ __forceinline__ unsigned xb_add(unsigned* p, unsigned v) { return __hip_atomic_fetch_add(p, v, __ATOMIC_RELAXED, __HIP_MEMORY_SCOPE_AGENT); }
__device__ __forceinline__ unsigned xb_xcc_id() { return (unsigned)__builtin_amdgcn_s_getreg((3 << 11) | 20) & 0xFu; }
#define XB_SPIN(cond, bar) do { unsigned _sp = 0; while (cond) { __builtin_amdgcn_s_sleep(1); \
    if ((++_sp & 255u) == 0u) { if (xb_ld(&(bar)[XB_TMO])) break; if (_sp > XB_SPIN_CAP) { atomicAdd(&(bar)[XB_TMO], 1u); break; } } } } while (0)

struct XcdBarrier {
    unsigned* bar; unsigned x;
    volatile LAS unsigned* st;
};

__device__ __forceinline__ XcdBarrier xcd_barrier_post(unsigned* bar, volatile LAS unsigned* st) {
    XcdBarrier b; b.bar = bar; b.x = xb_xcc_id(); b.st = st;
    if (threadIdx.x == 0) (void)xb_add(&bar[XB_XCNT(b.x)], 1u);
    return b;
}
__device__ __forceinline__ void xcd_barrier_complete(unsigned* bar, unsigned x, unsigned& nloc, unsigned& nx) {
    const unsigned G = gridDim.x * gridDim.y * gridDim.z;
    unsigned sum, cnt, mine, sp = 0u;
    for (;;) {
        sum = 0u; cnt = 0u; mine = 0u;
#pragma unroll
        for (unsigned j = 0; j < 16; ++j) { const unsigned c = xb_ld(&bar[XB_XCNT(j)]); sum += c; cnt += (c > 0u) ? 1u : 0u; mine = (j == x) ? c : mine; }
        if (sum == G) break;
        __builtin_amdgcn_s_sleep(1);
        if ((++sp & 255u) == 0u) { if (xb_ld(&bar[XB_TMO])) break; if (sp > XB_SPIN_CAP) { atomicAdd(&bar[XB_TMO], 1u); break; } }
    }
    nloc = mine > 0u ? mine : 1u; nx = cnt > 0u ? cnt : 1u;
}

__device__ __forceinline__ void xcd_barrier(const XcdBarrier& b) {
    asm volatile("s_waitcnt vmcnt(0)" ::: "memory");
    __syncthreads();
    if (threadIdx.x == 0) {
        unsigned* bar = b.bar;
        __builtin_amdgcn_s_waitcnt(0);
        unsigned nloc = b.st[0], nx = b.st[1];
        if (nloc == 0u) { xcd_barrier_complete(bar, b.x, nloc, nx); b.st[0] = nloc; b.st[1] = nx; }
        const unsigned old = xb_add(&bar[XB_XSUB(b.x)], 1u);
        const unsigned gen = old / nloc;
        if (old + 1u == (gen + 1u) * nloc) {
            __builtin_amdgcn_fence(__ATOMIC_RELEASE, "agent");
            asm volatile("s_waitcnt vmcnt(0)" ::: "memory");
            const unsigned og = xb_add(&bar[XB_TOP], 1u);
            const unsigned tg = og / nx;
            if (og + 1u == (tg + 1u) * nx) xb_add(&bar[XB_TOPGEN], 1u);
            else XB_SPIN(xb_ld(&bar[XB_TOPGEN]) == tg, bar);
            __builtin_amdgcn_fence(__ATOMIC_ACQUIRE, "agent");
            xb_add(&bar[XB_XGEN(b.x)], 1u);
            asm volatile("s_waitcnt vmcnt(0)" ::: "memory");
        } else {
            XB_SPIN(xb_ld(&bar[XB_XGEN(b.x)]) == gen, bar);
            __builtin_amdgcn_fence(__ATOMIC_ACQUIRE, "agent");
            asm volatile("s_waitcnt vmcnt(0)" ::: "memory");
        }
    }
    __syncthreads();
}
struct Ctx {
    LAS unsigned char* lds;
    volatile LAS unsigned* MISC;
    gu32* ctl;
    int tid, lane, wave, G, bid;
    float* out; unsigned char* ws;
};
__device__ __forceinline__ const float* inp(const Ctx& F, int i) { const unsigned long long v = *(volatile LAS unsigned long long*)(F.lds + INTAB_OFF + 8 * i);
    const unsigned lo = __builtin_amdgcn_readfirstlane((unsigned)v), hi = __builtin_amdgcn_readfirstlane((unsigned)(v >> 32)); return (const float*)(const GAS float*)(((unsigned long long)hi << 32) | lo); }
#define WSP(T, off) ((T*)(F.ws + (off)))
__device__ __forceinline__ void sincos_rev(float ang, float& s, float& c) {
    float t = ang * 0.15915494309189535f; t -= rintf(t); s = __builtin_amdgcn_sinf(t); c = __builtin_amdgcn_cosf(t); }

__device__ __forceinline__ void transpose_item(const float* W, int Nsrc, int nsrc0  , int k0, bf16* WT, int K, int ndst0, LAS float* scr, int lane, int kd = 0  ) {
    const int c = lane & 7;
    if (nsrc0 < 0) {
#pragma unroll
        for (int j = 0; j < 4; ++j) { const int n = (lane >> 3) + 8 * j; *(GAS v4u*)(WT + (size_t)(ndst0 + n) * K + kd + k0 + 8 * c) = (v4u){0u, 0u, 0u, 0u}; }
        return;
    }
    float wv[32];
#pragma unroll
    for (int i = 0; i < 32; ++i) wv[i] = *(const GAS float*)(W + (size_t)(k0 + 2 * i + (lane >> 5)) * Nsrc + nsrc0 + (lane & 31));
#pragma unroll
    for (int i = 0; i < 32; ++i) scr[(2 * i + (lane >> 5)) * 33 + (lane & 31)] = wv[i];
    LDS_WAIT(); asm volatile("" ::: "memory");
#pragma unroll
    for (int j = 0; j < 4; ++j) { const int n = (lane >> 3) + 8 * j; const LAS float* s = scr + (8 * c) * 33 + n;
        v4u o; o.x = pk2(s[0 * 33], s[1 * 33]); o.y = pk2(s[2 * 33], s[3 * 33]); o.z = pk2(s[4 * 33], s[5 * 33]); o.w = pk2(s[6 * 33], s[7 * 33]);
        *(GAS v4u*)(WT + (size_t)(ndst0 + n) * K + kd + k0 + 8 * c) = o; }
    LDS_WAIT(); asm volatile("" ::: "memory");
}
constexpr int TI_IN = 64 * (NP / 32), TI_GLU = 16 * 32, TI_PS = 16 * 128, TI_PA = 32 * 128, TI_O = 64 * 128;
constexpr int TI_PER_L = TI_IN + TI_GLU + 2 * TI_PS + TI_PA + TI_O;
constexpr int TJ_ITEMS = 32, TJ_JOBS = TI_PER_L / TJ_ITEMS;
__device__ __forceinline__ void transpose_one(Ctx& F, int l, int r, LAS float* scr) {
    if (r < TI_IN) { const int nblk = NP / 32, kb = r / nblk, nb = r % nblk, nd = nb * 32;
        const int ns = nd < 5120 ? nd : (nd < 22528 ? nd + 32 : (nd < 22560 ? nd - 22528 + 5120 : -1));
        transpose_item(inp(F, I_WIN) + (size_t)l * DM * NIN, NIN, ns, kb * 64, WSP(bf16, WS_WIN) + (size_t)l * NP * DM, DM, nd, scr, F.lane); return; }
    r -= TI_IN;
    if (r < TI_GLU) { const int kb = r / 32, nb = r % 32; transpose_item(inp(F, I_WGLU) + (size_t)l * 1024 * 1024, 1024, nb * 32, kb * 64, WSP(bf16, WS_WGLU) + (size_t)l * 1024 * 1024, 1024, nb * 32, scr, F.lane); return; }
    r -= TI_GLU;
    if (r < TI_PS) { const int kb = r / 128, nb = r % 128; transpose_item(inp(F, I_WPS) + (size_t)l * 1024 * DM, DM, nb * 32, kb * 64, WSP(bf16, WS_WCAT) + (size_t)l * DM * DM, DM, nb * 32, scr, F.lane, 0); return; }
    r -= TI_PS;
    if (r < TI_PS) { const int kb = r / 128, nb = r % 128; transpose_item(inp(F, I_WPG) + (size_t)l * 1024 * DM, DM, nb * 32, kb * 64, WSP(bf16, WS_WCAT) + (size_t)l * DM * DM, DM, nb * 32, scr, F.lane, 1024); return; }
    r -= TI_PS;
    if (r < TI_PA) { const int kb = r / 128, nb = r % 128; transpose_item(inp(F, I_WPA) + (size_t)l * 2048 * DM, DM, nb * 32, kb * 64, WSP(bf16, WS_WCAT) + (size_t)l * DM * DM, DM, nb * 32, scr, F.lane, 2048); return; }
    r -= TI_PA;
    { const int kb = r / 128, nb = r % 128; transpose_item(inp(F, I_WOUT) + (size_t)l * DM * DM, DM, nb * 32, kb * 64, WSP(bf16, WS_WO) + (size_t)l * DM * DM, DM, nb * 32, scr, F.lane); }
}
__device__ __forceinline__ void ph_transposes(Ctx& F) {
    LAS float* scr = (LAS float*)(F.lds + RING_OFF + F.wave * 16384);
    const int gw = F.bid * NWAVES + F.wave, NGW = F.G * NWAVES;
    for (int r = gw; r < TI_PER_L; r += NGW) transpose_one(F, 0, r, scr);
}
__device__ __forceinline__ void transpose_job(Ctx& F, int layer, int j) {
    LAS float* scr = (LAS float*)(F.lds + RING_OFF + F.wave * 16384);
#pragma unroll 1
    for (int i = 0; i < TJ_ITEMS / NWAVES; ++i) transpose_one(F, layer, j * TJ_ITEMS + i * NWAVES + F.wave, scr);
}
__device__ __forceinline__ void transposes_fill(Ctx& F, unsigned* cnt, int jlo, int jhi) {
    LAS float* scr = (LAS float*)(F.lds + RING_OFF + F.wave * 16384);
    for (;;) {
        __syncthreads();
        if (F.tid == 0) F.MISC[17] = __hip_atomic_fetch_add(cnt, 1u, RLX_AGENT);
        __syncthreads();
        const int j = jlo + (int)F.MISC[17];
        if (j >= jhi) break;
#pragma unroll 1
        for (int i = 0; i < TJ_ITEMS / NWAVES; ++i) transpose_one(F, 1, j * TJ_ITEMS + i * NWAVES + F.wave, scr);
    }
}
__device__ __forceinline__ void mod_partial_item(Ctx& F, int item) {
    LAS float* sc = (LAS float*)(F.lds + RING_OFF);
    {
        const int l = item / 192, rem = item % 192, nblk = rem / 32, ks = rem % 32;
        __syncthreads();
        if (F.tid < 384) { const int rr = F.tid / 128, kk = F.tid % 128; const float v = rr < 2 ? inp(F, I_C)[rr * DM + ks * 128 + kk] : inp(F, I_CCTX)[ks * 128 + kk]; sc[F.tid] = siluf_(v); }
        __syncthreads();
        const int n = nblk * 2048 + F.tid * 4;
        const float* w = inp(F, I_WMOD) + ((size_t)l * DM + (size_t)ks * 128) * 12288 + n;
        f32x4 a0 = {0.f, 0.f, 0.f, 0.f}, a1 = a0, a2 = a0;
#pragma unroll 8
        for (int kk = 0; kk < 128; ++kk) { const f32x4 wv = *(const GAS f32x4*)(w + (size_t)kk * 12288); a0 += sc[kk] * wv; a1 += sc[128 + kk] * wv; a2 += sc[256 + kk] * wv; }
        float* o = WSP(float, WS_MODP) + ((size_t)(l * 32 + ks) * 3) * 12288 + n;
        *(f32x4*)o = a0; *(f32x4*)(o + 12288) = a1; *(f32x4*)(o + 2 * 12288) = a2;
    }
    __syncthreads();
}
__device__ __forceinline__ void ph_mod_reduce(Ctx& F) {
    const float* mp = WSP(float, WS_MODP); float* mo = WSP(float, WS_MOD);
    for (int e = F.bid * NTHR + F.tid; e < 2 * 3 * 12288; e += F.G * NTHR) {
        const int l = e / 36864, rem = e % 36864, r = rem / 12288, n = rem % 12288;
        float s = inp(F, I_BMOD)[l * 12288 + n];
        for (int ks = 0; ks < 32; ++ks) s += mp[((size_t)(l * 32 + ks) * 3 + r) * 12288 + n];
        mo[e] = s;
    }
}
__device__ __forceinline__ void ph_rope_table(Ctx& F) {
    float* tb = WSP(float, WS_ROPE);
    for (int e = F.bid * NTHR + F.tid; e < 2048; e += F.G * NTHR) {
        const int pos = e >> 5, f = e & 31;
        const float inv = exp2f(-(float)f * (13.287712379549449f / 32.0f));
        float s, c; sincos_rev((float)pos * inv, s, c);
        tb[e] = c; tb[2048 + e] = s;
    }
}
__device__ __forceinline__ void s5_mats_item(Ctx& F, int item) {
    LAS float* L = (LAS float*)(F.lds + RING_OFF);
    LAS float* zr = L; LAS float* zi = L + 64; LAS float* qr = L + 128; LAS float* qi = L + 192;
    LAS float* bbr = L + 256; LAS float* bbi = bbr + 1024;
    LAS float* cmr = bbi + 1024; LAS float* cmi = cmr + 1024;
    LAS float* pdr = cmi + 1024; LAS float* pdi = pdr + 1024;
    {
        const int ld = item >> 6, g = item & 63;
        bf16* TG = WSP(bf16, WS_TG) + (size_t)item * 256 * 384;
        bf16* WT = WSP(bf16, WS_WT) + (size_t)item * 128 * 256;
        float* L16 = WSP(float, WS_L16) + (size_t)item * 128;
        __syncthreads();
        if (F.tid < 64) { const int n = F.tid; const size_t pi = ((size_t)ld * 64 + g) * 64 + n;
            const float lr = fminf(inp(F, I_LAMRE)[pi], -1e-4f), li = inp(F, I_LAMIM)[pi], dt = __expf(inp(F, I_LOGDT)[ld * 64 + g]);
            const float a = lr * dt, b = li * dt; zr[n] = a; zi[n] = b;
            float sb, cb, sh, ch; sincos_rev(b, sb, cb); sincos_rev(0.5f * b, sh, ch);
            const float em1 = expm1f(a), ea = em1 + 1.0f;
            const float nr = em1 * cb - 2.0f * sh * sh, ni = ea * sb;
            const float den = 1.0f / (lr * lr + li * li);
            qr[n] = (nr * lr + ni * li) * den; qi[n] = (ni * lr - nr * li) * den;
            float s16, c16; sincos_rev(16.0f * b, s16, c16); const float m16 = __expf(16.0f * a);
            L16[2 * n] = m16 * c16; L16[2 * n + 1] = m16 * s16; }
        __syncthreads();
        for (int e = F.tid; e < 1024; e += NTHR) {
            { const int n = e >> 4; const size_t bi = (((size_t)ld * 64 + g) * 64) * 16 + e; const float br = inp(F, I_BRE)[bi], bim = inp(F, I_BIM)[bi];
              bbr[e] = qr[n] * br - qi[n] * bim; bbi[e] = qr[n] * bim + qi[n] * br; }
            { const size_t ci = (((size_t)ld * 64 + g) * 16) * 64 + e; cmr[e] = inp(F, I_CRE)[ci]; cmi[e] = inp(F, I_CIM)[ci]; }
        }
        __syncthreads();
        for (int d = 0; d <= 16; ++d) {
            for (int e = F.tid; e < 1024; e += NTHR) {
                { const int n = e & 63; float s, c; sincos_rev((float)d * zi[n], s, c); const float mg = __expf((float)d * zr[n]); const float er = mg * c, ei = mg * s;
                  pdr[e] = cmr[e] * er - cmi[e] * ei; pdi[e] = cmr[e] * ei + cmi[e] * er; }
                if (d <= 15) { const int n = e >> 4, p = e & 15; float s, c; sincos_rev((float)d * zi[n], s, c); const float mg = __expf((float)d * zr[n]); const float er = mg * c, ei = mg * s;
                  const float vr = er * bbr[e] - ei * bbi[e], vi = er * bbi[e] + ei * bbr[e];
                  WT[(size_t)(2 * n) * 256 + (15 - d) * 16 + p] = (bf16)f2bf(vr); WT[(size_t)(2 * n + 1) * 256 + (15 - d) * 16 + p] = (bf16)f2bf(vi); }
            }
            __syncthreads();
            if (d <= 15 && F.tid < 256) { const int pp = F.tid >> 4, p = F.tid & 15; float s = 0.f;
                for (int n = 0; n < 64; ++n) s += pdr[pp * 64 + n] * bbr[n * 16 + p] - pdi[pp * 64 + n] * bbi[n * 16 + p];
                const bf16 v = (bf16)f2bf(s);
                for (int i = d; i < 16; ++i) TG[(size_t)(i * 16 + pp) * 384 + (i - d) * 16 + p] = v; }
            if (d >= 1) for (int e = F.tid; e < 1024; e += NTHR) { const int pp = e >> 6, n = e & 63;
                TG[(size_t)((d - 1) * 16 + pp) * 384 + 256 + 2 * n] = (bf16)f2bf(pdr[e]); TG[(size_t)((d - 1) * 16 + pp) * 384 + 256 + 2 * n + 1] = (bf16)f2bf(-pdi[e]); }
            __syncthreads();
        }
        for (int e = F.tid; e < 256 * 256; e += NTHR) { const int row = e >> 8, col = e & 255; if ((col >> 4) > (row >> 4)) TG[(size_t)row * 384 + col] = 0; }
    }
    __syncthreads();
}
__device__ __forceinline__ void ph_norm(Ctx& F, int layer, bool ctxsplit) {
    const int gw = F.bid * NWAVES + F.wave, NGW = F.G * NWAVES;
    const float* ng = inp(F, I_NORMG) + layer * DM; const float* MODl = WSP(float, WS_MOD) + (size_t)layer * 3 * 12288;
    for (int r = gw; r < MROWS; r += NGW) {
        const int b = r / RPB, j = r % RPB; const bool isctx = j < TC;
        const bool fold = (layer == 1 && isctx && ctxsplit);
        const float* src = (layer == 0 || fold) ? (isctx ? inp(F, I_CTX) + ((size_t)b * TC + j) * DM : inp(F, I_X) + ((size_t)b * TL + (j - TC)) * DM) : WSP(float, WS_X1) + (size_t)r * DM;
        const float* md = MODl + (size_t)(isctx ? 2 : b) * 12288;
        const GAS f32x4* xr = (const GAS f32x4*)src + F.lane;
        f32x4 v[16]; float s = 0.f;
#pragma unroll
        for (int q = 0; q < 16; ++q) v[q] = xr[64 * q];
        if (fold) { const float* g0v = WSP(float, WS_MOD) + (size_t)2 * 12288 + 8192 + 4 * F.lane; const float* pt = WSP(float, WS_PART) + ((size_t)b * 256 + j) * DM + 4 * F.lane;
#pragma unroll 1
            for (int ks = 0; ks < 8; ++ks) {
#pragma unroll
                for (int q = 0; q < 16; ++q) v[q] += *(const GAS f32x4*)(g0v + 256 * q) * *(const GAS f32x4*)(pt + 256 * q);
                pt += (size_t)512 * DM; } }
#pragma unroll
        for (int q = 0; q < 16; ++q) s += (v[q].x * v[q].x + v[q].y * v[q].y) + (v[q].z * v[q].z + v[q].w * v[q].w);
        const float rstd = 1.0f / sqrtf(wave_sum(s) * (1.0f / DM) + EPS);
        GAS v2u* o8 = (GAS v2u*)(WSP(bf16, WS_H) + (size_t)r * DM) + F.lane;
#pragma unroll
        for (int q = 0; q < 16; ++q) { const int d0 = 256 * q + 4 * F.lane;
            const f32x4 g4 = *(const GAS f32x4*)(ng + d0), sh = *(const GAS f32x4*)(md + d0), sc = *(const GAS f32x4*)(md + 4096 + d0);
            const f32x4 y = v[q] * rstd * g4 * (sc + 1.0f) + sh;
            o8[64 * q] = (v2u){pk2(y.x, y.y), pk2(y.z, y.w)}; }
    }
}
__device__ __forceinline__ void ph_final(Ctx& F) {
    const int gw = F.bid * NWAVES + F.wave, NGW = F.G * NWAVES; const float* fg = inp(F, I_FINALG);
    for (int r = gw; r < NB * TL; r += NGW) {
        GAS f32x4* xr = (GAS f32x4*)(F.out + (size_t)r * DM) + F.lane;
        f32x4 v[16]; float s = 0.f;
#pragma unroll
        for (int q = 0; q < 16; ++q) { v[q] = xr[64 * q]; s += (v[q].x * v[q].x + v[q].y * v[q].y) + (v[q].z * v[q].z + v[q].w * v[q].w); }
        const float rstd = 1.0f / sqrtf(wave_sum(s) * (1.0f / DM) + EPS);
#pragma unroll
        for (int q = 0; q < 16; ++q) { const f32x4 g4 = *(const GAS f32x4*)(fg + 256 * q + 4 * F.lane); xr[64 * q] = v[q] * rstd * g4; }
    }
}
__device__ __forceinline__ void attn_prep_rows(Ctx& F, int layer, int r_lo, int r_hi) {
    const bf16* P = WSP(bf16, WS_P); const float* tb = WSP(float, WS_ROPE);
    const float* gq = inp(F, I_AQG) + layer * 128; const float* gk = inp(F, I_AKG) + layer * 128;
    const int lane = F.lane, hq = lane >> 4, li = lane & 15, d0 = 8 * li;
    const f32x4 gqa = *(const GAS f32x4*)(gq + d0), gqb = *(const GAS f32x4*)(gq + d0 + 4), gka = *(const GAS f32x4*)(gk + d0), gkb = *(const GAS f32x4*)(gk + d0 + 4);
    const float sg = (li & 4) ? 1.0f : -1.0f; const int f0 = 8 * (li & 3);
    for (int it = r_lo * 2 + F.wave; it < r_hi * 2; it += NWAVES) {
        const int r = it >> 1, grp = 4 + (it & 1); const int j = r % RPB; const bool isctx = j < TC;
        const int scol = grp < 4 ? C_AQ + grp * 512 : (grp == 4 ? C_AK : C_AV);
        const v4u w = *(const GAS v4u*)(P + (size_t)r * NP + scol + hq * 128 + d0);
        if (grp == 5) { *(GAS v4u*)(WSP(bf16, WS_VN) + (size_t)r * 512 + hq * 128 + d0) = w; continue; }
        f32x4 xa = (f32x4){bflo(w.x), bfhi(w.x), bflo(w.y), bfhi(w.y)}, xb = (f32x4){bflo(w.z), bfhi(w.z), bflo(w.w), bfhi(w.w)};
        float ss = (xa.x * xa.x + xa.y * xa.y) + (xa.z * xa.z + xa.w * xa.w) + (xb.x * xb.x + xb.y * xb.y) + (xb.z * xb.z + xb.w * xb.w);
        ss += __shfl_xor(ss, 1); ss += __shfl_xor(ss, 2); ss += __shfl_xor(ss, 4); ss += __shfl_xor(ss, 8);
        const float rstd = 1.0f / sqrtf(ss * (1.0f / 128.0f) + EPS);
        xa = xa * rstd * (grp < 4 ? gqa : gka); xb = xb * rstd * (grp < 4 ? gqb : gkb);
        if (!isctx) {
            const int t = j - TC; const int pos = (li >> 3) ? (t & 63) : (t >> 6);
            const f32x4 ca = *(const GAS f32x4*)(tb + pos * 32 + f0), cb = *(const GAS f32x4*)(tb + pos * 32 + f0 + 4), sa = *(const GAS f32x4*)(tb + 2048 + pos * 32 + f0), sb = *(const GAS f32x4*)(tb + 2048 + pos * 32 + f0 + 4);
            f32x4 pa, pb;
#pragma unroll
            for (int e = 0; e < 4; ++e) { pa[e] = __shfl_xor(xa[e], 4); pb[e] = __shfl_xor(xb[e], 4); }
            xa = xa * ca + sg * pa * sa; xb = xb * cb + sg * pb * sb;
        }
        const v4u o = (v4u){pk2(xa.x, xa.y), pk2(xa.z, xa.w), pk2(xb.x, xb.y), pk2(xb.z, xb.w)};
        bf16* dst = grp < 4 ? WSP(bf16, WS_QN) + (size_t)r * 2048 + (grp * 4 + hq) * 128 + d0 : WSP(bf16, WS_KN) + (size_t)r * 512 + hq * 128 + d0;
        *(GAS v4u*)dst = o;
    }
}
__device__ __forceinline__ float log_sigmoid_(float z) { return fminf(z, 0.f) - __logf(1.0f + __expf(-fabsf(z))); }
__device__ __forceinline__ void gla_prep_item(Ctx& F, int layer, int it) {
    const bf16* P = WSP(bf16, WS_P);
    LAS float* lrs = (LAS float*)(F.lds + RING_OFF);
    LAS unsigned char* tq = F.lds + RING_OFF + 4096 + F.wave * 17408;
    LAS unsigned char* tk = tq + 4608;
    LAS float* bbs = (LAS float*)(tq + 9216) + F.lane;
    const int lane = F.lane, h = F.wave, col = h * 64 + lane, fr = lane & 15, fq = lane >> 4;
    {
        const int b = it / GNCH, c = it % GNCH; const size_t r0 = (size_t)b * RPB + (size_t)c * GCH;
        __syncthreads();
        { const int tok = F.tid >> 4, cc = (F.tid & 15) * 2; const unsigned w = *(const GAS unsigned*)(P + (r0 + tok) * NP + C_LR + cc); lrs[tok * 32 + cc] = bflo(w); lrs[tok * 32 + cc + 1] = bfhi(w); }
        __syncthreads();
        bf16 qraw[32], kraw[32];
        { const bf16* pq = P + r0 * NP + C_GQ + col;
#pragma unroll
          for (int t = 0; t < 32; ++t) { qraw[t] = pq[(size_t)t * NP]; kraw[t] = pq[(size_t)t * NP + (C_GK - C_GQ)]; } }
#pragma unroll 1
        for (int dir = 0; dir < 2; ++dir) {
            float wa[16];
#pragma unroll
            for (int r = 0; r < 16; ++r) wa[r] = inp(F, I_GWA)[((size_t)(layer * 2 + dir) * 16 + r) * 512 + col];
            const float ba = inp(F, I_GBA)[(layer * 2 + dir) * 512 + col];
#pragma unroll 2
            for (int t = 0; t < 32; ++t) { float z = ba;
#pragma unroll
                for (int r = 0; r < 16; ++r) z += lrs[t * 32 + dir * 16 + r] * wa[r];
                bbs[64 * t] = log_sigmoid_(z) * (1.0f / 16.0f); }
            float run = 0.f;
            if (dir == 0) {
#pragma unroll 4
                for (int t = 0; t < 32; ++t) { run += bbs[64 * t]; bbs[64 * t] = run; }
            } else {
#pragma unroll 4
                for (int t = 31; t >= 0; --t) { run += bbs[64 * t]; bbs[64 * t] = run; }
            }
            const float bend = run;
            bf16* QH = WSP(bf16, WS_QH) + (size_t)dir * MROWS * 512;
            bf16* KHT = WSP(bf16, WS_KHT) + ((((size_t)dir * 272 + it) * 8 + h) * 64 + lane) * 32;
#pragma unroll
            for (int tg = 0; tg < 4; ++tg) { unsigned kw[4];
#pragma unroll
                for (int i2 = 0; i2 < 4; ++i2) { float khv[2];
#pragma unroll
                    for (int e = 0; e < 2; ++e) { const int t = 8 * tg + 2 * i2 + e; const float bt = bbs[64 * t];
                        const float q = bf2f(qraw[t]) * 0.125f, k = bf2f(kraw[t]);
                        const float qh = q * __expf(bt), kt = k * __expf(-bt); khv[e] = k * __expf(bend - bt);
                        const bf16 qb = (bf16)f2bf(qh);
                        QH[(r0 + t) * 512 + col] = qb;
                        *(LAS bf16*)(tq + t * 144 + lane * 2) = qb; *(LAS bf16*)(tk + t * 144 + lane * 2) = (bf16)f2bf(kt); }
                    kw[i2] = pk2(khv[0], khv[1]); }
                *(GAS v4u*)(KHT + 8 * tg) = (v4u){kw[0], kw[1], kw[2], kw[3]}; }
            WSP(float, WS_DEC)[((size_t)dir * 272 + it) * 512 + col] = __expf(bend);
            LDS_WAIT(); asm volatile("" ::: "memory");
            bf16x8 af[2][2], bfr[2][2];
#pragma unroll
            for (int mb = 0; mb < 2; ++mb)
#pragma unroll
                for (int s = 0; s < 2; ++s) { af[mb][s] = *(const LAS bf16x8*)(tk + (16 * mb + fr) * 144 + 64 * s + 16 * fq); bfr[mb][s] = *(const LAS bf16x8*)(tq + (16 * mb + fr) * 144 + 64 * s + 16 * fq); }
            LDS_WAIT(); asm volatile("" ::: "memory");
            bf16* AM = WSP(bf16, WS_AM) + (((size_t)dir * 272 + it) * 8 + h) * 1024;
#pragma unroll
            for (int mb = 0; mb < 2; ++mb)
#pragma unroll
                for (int nb = 0; nb < 2; ++nb) { f32x4 dacc = {0.f, 0.f, 0.f, 0.f};
                    dacc = __builtin_amdgcn_mfma_f32_16x16x32_bf16(af[mb][0], bfr[nb][0], dacc, 0, 0, 0);
                    dacc = __builtin_amdgcn_mfma_f32_16x16x32_bf16(af[mb][1], bfr[nb][1], dacc, 0, 0, 0);
                    const int i = 16 * nb + fr, j0 = 16 * mb + 4 * fq; float vv[4];
#pragma unroll
                    for (int r = 0; r < 4; ++r) { const int j = j0 + r; const bool keep = dir == 0 ? (j <= i) : (j >= i); vv[r] = keep ? dacc[r] : 0.f; }
                    *(GAS v2u*)(AM + i * 32 + j0) = (v2u){pk2(vv[0], vv[1]), pk2(vv[2], vv[3])}; }
        }
#pragma unroll 1
        for (int half = 0; half < 2; ++half) { const int v = lane + 64 * half; bf16* VT = WSP(bf16, WS_VT) + (((size_t)it * 8 + h) * 128 + v) * 32;
            const bf16* pv = P + r0 * NP + C_GV + h * 128 + v;
            bf16 vr[32];
#pragma unroll
            for (int t = 0; t < 32; ++t) vr[t] = pv[(size_t)t * NP];
#pragma unroll
            for (int tg = 0; tg < 4; ++tg) *(GAS v4u*)(VT + 8 * tg) = (v4u){(unsigned)vr[8 * tg] | ((unsigned)vr[8 * tg + 1] << 16), (unsigned)vr[8 * tg + 2] | ((unsigned)vr[8 * tg + 3] << 16),
                                                                            (unsigned)vr[8 * tg + 4] | ((unsigned)vr[8 * tg + 5] << 16), (unsigned)vr[8 * tg + 6] | ((unsigned)vr[8 * tg + 7] << 16)}; }
    }
    __syncthreads();
}
constexpr int GLA_SLOT = 18688, GLA_R = 7, GLA_D = 6, GLA_JUNK = GLA_R * GLA_SLOT;
__device__ __forceinline__ int gla_chunk_of(int dir, int ci) { return dir == 0 ? ci : (ci < GNCTX ? GNCTX - 1 - ci : GNCH - 1 + GNCTX - ci); }
__device__ __forceinline__ void gla_issue(Ctx& F, int dir, int b, int h, int c, int slot) {
    const int lane = F.lane, w = F.wave; const int it = b * GNCH + c; const size_t di = (size_t)dir * 272 + it;
    LAS unsigned char* sl = F.lds + RING_OFF + slot * GLA_SLOT;
    const unsigned char* vt = (const unsigned char*)(WSP(bf16, WS_VT) + ((size_t)it * 8 + h) * 4096);
    __builtin_amdgcn_global_load_lds((const GAS unsigned*)(vt + 1024 * w + 16 * lane), (LAS unsigned*)(sl + 1024 * w), 16, 0, 0);
    if (w < 4) { const unsigned char* kh = (const unsigned char*)(WSP(bf16, WS_KHT) + (di * 8 + h) * 2048);
        __builtin_amdgcn_global_load_lds((const GAS unsigned*)(kh + 1024 * w + 16 * lane), (LAS unsigned*)(sl + 8192 + 1024 * w), 16, 0, 0); }
    else { const unsigned char* qh = (const unsigned char*)(WSP(bf16, WS_QH) + ((size_t)dir * MROWS + (size_t)b * RPB + (size_t)c * GCH + 8 * (w - 4) + (lane >> 3)) * 512 + h * 64);
        __builtin_amdgcn_global_load_lds((const GAS unsigned*)(qh + 16 * (lane & 7)), (LAS unsigned*)(sl + 12288 + 1024 * (w - 4)), 16, 0, 0); }
    if (w < 2) { const unsigned char* am = (const unsigned char*)(WSP(bf16, WS_AM) + (di * 8 + h) * 1024);
        __builtin_amdgcn_global_load_lds((const GAS unsigned*)(am + 1024 * w + 16 * lane), (LAS unsigned*)(sl + 16384 + 1024 * w), 16, 0, 0); }
    else if (w == 2) { const unsigned char* dc = (const unsigned char*)(WSP(float, WS_DEC) + di * 512 + h * 64);
        if (lane < 16) __builtin_amdgcn_global_load_lds((const GAS unsigned*)(dc + 16 * lane), (LAS unsigned*)(sl + 18432), 16, 0, 0); }
    else __builtin_amdgcn_global_load_lds((const GAS unsigned*)(vt + 16 * lane), (LAS unsigned*)(F.lds + RING_OFF + GLA_JUNK), 16, 0, 0);
}
__device__ __forceinline__ void gla_seq_job(Ctx& F, int layer, int job) {
    const int dir = job >> 4, b = (job >> 3) & 1, h = job & 7; const int lane = F.lane, fr = lane & 15, fq = lane >> 4, w = F.wave;
    f32x4 S[4];
#pragma unroll
    for (int m = 0; m < 4; ++m) S[m] = (f32x4){0.f, 0.f, 0.f, 0.f};
    float* GO = WSP(float, WS_GO) + (size_t)dir * MROWS * 1024;
    asm volatile("s_waitcnt vmcnt(0)" ::: "memory"); __builtin_amdgcn_s_barrier();
#pragma unroll 1
    for (int c0 = 0; c0 < GLA_D - 1; ++c0) gla_issue(F, dir, b, h, gla_chunk_of(dir, c0), c0);
    asm volatile("s_waitcnt vmcnt(0)" ::: "memory");
#pragma unroll 1
    for (int ci = 0; ci < GNCH; ++ci) {
        const int c = gla_chunk_of(dir, ci);
        { const int cn = ci + GLA_D - 1; gla_issue(F, dir, b, h, gla_chunk_of(dir, cn < GNCH ? cn : GNCH - 1), cn % GLA_R); }
        asm volatile("s_waitcnt vmcnt(55)" ::: "memory");
        __builtin_amdgcn_s_barrier(); asm volatile("" ::: "memory");
        const LAS unsigned char* sl = F.lds + RING_OFF + (ci % GLA_R) * GLA_SLOT;
        const bf16x8 vt = *(const LAS bf16x8*)(sl + (16 * w + fr) * 64 + 16 * fq);
        bf16x4 qa[2][2], qb[2][2]; bf16x8 am[2], kh[4]; f32x4 dec[4];
#pragma unroll
        for (int ib = 0; ib < 2; ++ib) {
#pragma unroll
            for (int s = 0; s < 2; ++s) { const LAS unsigned char* qp = sl + 12288 + (16 * ib + fr) * 128 + (32 * s + 4 * fq) * 2; qa[ib][s] = *(const LAS bf16x4*)qp; qb[ib][s] = *(const LAS bf16x4*)(qp + 32); }
            am[ib] = *(const LAS bf16x8*)(sl + 16384 + (16 * ib + fr) * 64 + 16 * fq); }
#pragma unroll
        for (int m = 0; m < 4; ++m) { dec[m] = *(const LAS f32x4*)(sl + 18432 + (16 * m + 4 * fq) * 4); kh[m] = *(const LAS bf16x8*)(sl + 8192 + (16 * m + fr) * 64 + 16 * fq); }
        bf16x8 sb[2];
#pragma unroll
        for (int s = 0; s < 2; ++s) { const v4u wv = (v4u){pg8::cvt_pk_bf16(S[2 * s][0], S[2 * s][1]), pg8::cvt_pk_bf16(S[2 * s][2], S[2 * s][3]), pg8::cvt_pk_bf16(S[2 * s + 1][0], S[2 * s + 1][1]), pg8::cvt_pk_bf16(S[2 * s + 1][2], S[2 * s + 1][3])};
            sb[s] = __builtin_bit_cast(bf16x8, wv); }
        asm volatile("s_waitcnt lgkmcnt(0)" ::: "memory"); __builtin_amdgcn_sched_barrier(0);
        f32x4 o[2];
#pragma unroll
        for (int ib = 0; ib < 2; ++ib) { o[ib] = (f32x4){0.f, 0.f, 0.f, 0.f};
#pragma unroll
            for (int s = 0; s < 2; ++s) { const bf16x8 qf = (bf16x8){qa[ib][s][0], qa[ib][s][1], qa[ib][s][2], qa[ib][s][3], qb[ib][s][0], qb[ib][s][1], qb[ib][s][2], qb[ib][s][3]};
                o[ib] = __builtin_amdgcn_mfma_f32_16x16x32_bf16(qf, sb[s], o[ib], 0, 0, 0); } }
#pragma unroll
        for (int m = 0; m < 4; ++m) { S[m] = S[m] * dec[m]; S[m] = __builtin_amdgcn_mfma_f32_16x16x32_bf16(kh[m], vt, S[m], 0, 0, 0); }
#pragma unroll
        for (int ib = 0; ib < 2; ++ib) { o[ib] = __builtin_amdgcn_mfma_f32_16x16x32_bf16(am[ib], vt, o[ib], 0, 0, 0);
            float* op = GO + ((size_t)b * RPB + (size_t)c * GCH + 16 * ib + 4 * fq) * 1024 + h * 128 + 16 * w + fr;
#pragma unroll
            for (int r = 0; r < 4; ++r) op[(size_t)r * 1024] = o[ib][r]; }
    }
    asm volatile("s_waitcnt vmcnt(0)" ::: "memory"); __builtin_amdgcn_s_barrier();
}
__device__ __forceinline__ void ph_gla_post(Ctx& F, int layer, int nu) {
    if (F.bid < nu) return;
    const int gw = (F.bid - nu) * NWAVES + F.wave, NGW = (F.G - nu) * NWAVES; const int lane = F.lane;
    const float* g0 = WSP(float, WS_GO); const float* g1 = g0 + (size_t)MROWS * 1024; const bf16* P = WSP(bf16, WS_P);
    const float* go = inp(F, I_GNORM) + layer * 128;
    const float gg0 = go[2 * lane], gg1 = go[2 * lane + 1];
    for (int it = gw; it < MROWS * 8; it += NGW) {
        const int r = it >> 3, h = it & 7; if (layer == 1 && (r % RPB) < TC) continue;
        const size_t o = (size_t)r * 1024 + h * 128 + 2 * lane;
        const f32x2 a = *(const GAS f32x2*)(g0 + o), bq = *(const GAS f32x2*)(g1 + o);
        const float y0 = a.x + bq.x, y1 = a.y + bq.y;
        const float rstd = 1.0f / sqrtf(wave_sum(y0 * y0 + y1 * y1) * (1.0f / 128.0f) + EPS);
        const unsigned zw = *(const GAS unsigned*)(P + (size_t)r * NP + C_GZ + h * 128 + 2 * lane);
        *(GAS unsigned*)(WSP(bf16, WS_ACAT) + (size_t)r * DM + 1024 + h * 128 + 2 * lane) = pk2(y0 * rstd * gg0 * bflo(zw), y1 * rstd * gg1 * bfhi(zw));
    }
}
__device__ __forceinline__ void ph_attn_gate(Ctx& F, int layer) {
    const bf16* P = WSP(bf16, WS_P); bf16* AT = WSP(bf16, WS_AT);
    for (size_t e = (size_t)F.bid * NTHR + F.tid; e < (size_t)MROWS * 256; e += (size_t)F.G * NTHR) {
        const size_t r = e >> 8; const int c8 = (int)(e & 255) * 8; if (layer == 1 && (r % RPB) < TC) continue;
        const v4u a = *(const GAS v4u*)(AT + r * 2048 + c8), g = *(const GAS v4u*)(P + r * NP + C_AZ + c8);
        v4u o; o.x = pk2(bflo(a.x) * bflo(g.x), bfhi(a.x) * bfhi(g.x)); o.y = pk2(bflo(a.y) * bflo(g.y), bfhi(a.y) * bfhi(g.y));
        o.z = pk2(bflo(a.z) * bflo(g.z), bfhi(a.z) * bfhi(g.z)); o.w = pk2(bflo(a.w) * bflo(g.w), bfhi(a.w) * bfhi(g.w));
        *(GAS v4u*)(WSP(bf16, WS_ACAT) + r * DM + 2048 + c8) = o;
    }
}
__device__ __forceinline__ int s5_jrow(int dir, int so) { return dir == 0 ? so : (so < TC ? TC - 1 - so : RPB + TC - 1 - so); }
__device__ __forceinline__ int s5_uoff(int j) { return (j * 32) ^ (((j >> 4) & 7) << 5); }
constexpr int S5_XCH_OFF = RPB * 32;
__device__ __forceinline__ void s5_job(Ctx& F, int layer, int job) {
    const int b = job >> 6, g = job & 63; const int lane = F.lane, fr = lane & 15, fq = lane >> 4, w = F.wave;
    const bf16* P = WSP(bf16, WS_P);
    LAS unsigned char* UL = F.lds + RING_OFF; LAS f32x2* XCH = (LAS f32x2*)(F.lds + RING_OFF + S5_XCH_OFF);
    float* E = WSP(float, WS_E) + (size_t)job * SNCH * 128; bf16* HS = WSP(bf16, WS_HS) + (size_t)job * SNCH * 128;
    float* YF = WSP(float, WS_YF); bf16* GB = WSP(bf16, WS_GB);
    __syncthreads();
    { v4u uv[17];
#pragma unroll
      for (int q = 0; q < 17; ++q) { const int idx = F.tid + 512 * q; uv[q] = *(const GAS v4u*)(WSP(bf16, WS_UB) + ((size_t)b * 64 + g) * RPB * 16 + (size_t)idx * 8); }
#pragma unroll
      for (int q = 0; q < 17; ++q) { const int idx = F.tid + 512 * q; *(LAS v4u*)(UL + s5_uoff(idx >> 1) + (idx & 1) * 16) = uv[q]; } }
    __syncthreads();
#pragma unroll 1
    for (int dir = 0; dir < 2; ++dir) {
        const int item = (layer * 2 + dir) * 64 + g;
        const bf16* TG = WSP(bf16, WS_TG) + (size_t)item * 256 * 384; const bf16* WT = WSP(bf16, WS_WT) + (size_t)item * 128 * 256; const float* L16 = WSP(float, WS_L16) + (size_t)item * 128;
        {
            bf16x8 bw[8];
#pragma unroll
            for (int s = 0; s < 8; ++s) bw[s] = *(const GAS bf16x8*)(WT + (size_t)(16 * w + fr) * 256 + 32 * s + 8 * fq);
#pragma unroll 1
            for (int mb_ = 0; mb_ < 17; ++mb_) { int mb = mb_; asm volatile("" : "+s"(mb)); f32x4 acc = {0.f, 0.f, 0.f, 0.f}; const int k = 16 * mb + fr;
#pragma unroll
                for (int s = 0; s < 8; ++s) { const bf16x8 a = *(const LAS bf16x8*)(UL + s5_uoff(s5_jrow(dir, 16 * k + 2 * s + (fq >> 1))) + (fq & 1) * 16); acc = __builtin_amdgcn_mfma_f32_16x16x32_bf16(a, bw[s], acc, 0, 0, 0); }
#pragma unroll
                for (int r = 0; r < 4; ++r) E[(size_t)(16 * mb + 4 * fq + r) * 128 + 16 * w + fr] = acc[r]; }
        }
        VM_WAIT(); __syncthreads();
        { const float pr = L16[2 * lane], pi = L16[2 * lane + 1]; const int k0 = 34 * w;
            float er[34], ei[34];
            { const float* ep = E + (size_t)k0 * 128 + 2 * lane;
#pragma unroll
              for (int q = 0; q < 34; ++q) { const f32x2 t = *(const GAS f32x2*)ep; er[q] = t.x; ei[q] = t.y; ep += 128; asm volatile("" : "+v"(ep)); } }
            float lr = 0.f, li = 0.f;
#pragma unroll
            for (int q = 0; q < 34; ++q) { const float tx = er[q], ty = ei[q]; er[q] = lr; ei[q] = li; const float nr = pr * lr - pi * li + tx, ni = pr * li + pi * lr + ty; lr = nr; li = ni; }
            float qr = pr, qi = pi, p2r, p2i;
            { float tr = qr * qr - qi * qi, ti = 2.f * qr * qi; qr = tr; qi = ti; p2r = qr; p2i = qi; }
#pragma unroll
            for (int q = 0; q < 4; ++q) { const float tr = qr * qr - qi * qi, ti = 2.f * qr * qi; qr = tr; qi = ti; }
            const float p34r = qr * p2r - qi * p2i, p34i = qr * p2i + qi * p2r;
            XCH[w * 64 + lane] = (f32x2){lr, li};
            LDS_WAIT(); __syncthreads();
            float cr = 0.f, ci = 0.f;
            for (int v = 0; v < w; ++v) { const f32x2 x = XCH[v * 64 + lane]; const float nr = p34r * cr - p34i * ci + x.x, ni = p34r * ci + p34i * cr + x.y; cr = nr; ci = ni; }
            float wr_ = 1.f, wi_ = 0.f; bf16* hp = HS + (size_t)k0 * 128 + 2 * lane;
#pragma unroll
            for (int q = 0; q < 34; ++q) { const float hr = wr_ * cr - wi_ * ci + er[q], hi = wr_ * ci + wi_ * cr + ei[q];
                *(GAS unsigned*)hp = pk2(hr, hi); hp += 128; asm volatile("" : "+v"(hp));
                const float nr = wr_ * pr - wi_ * pi, ni = wr_ * pi + wi_ * pr; wr_ = nr; wi_ = ni; } }
        VM_WAIT(); __syncthreads();
        {
            bf16x8 bt[2][12];
#pragma unroll
            for (int nb = 0; nb < 2; ++nb)
#pragma unroll
                for (int s = 0; s < 12; ++s) bt[nb][s] = *(const GAS bf16x8*)(TG + (size_t)((2 * w + nb) * 16 + fr) * 384 + 32 * s + 8 * fq);
            const float dsk = inp(F, I_SSMD)[layer * 1024 + g * 16 + fr];
            bf16x8 hn[4], hn2[4]; float yn[2][4];
#pragma unroll
            for (int s = 0; s < 4; ++s) { hn[s] = *(const GAS bf16x8*)(HS + (size_t)fr * 128 + 32 * s + 8 * fq); hn2[s] = *(const GAS bf16x8*)(HS + (size_t)(16 + fr) * 128 + 32 * s + 8 * fq); }
#pragma unroll
            for (int nb = 0; nb < 2; ++nb)
#pragma unroll
                for (int r = 0; r < 4; ++r) { yn[nb][r] = 0.f; if (dir == 1) yn[nb][r] = YF[(((size_t)b * 64 + g) * RPB + s5_jrow(1, 16 * (4 * fq + r) + 2 * w + nb)) * 16 + fr]; }
#pragma unroll 1
            for (int mb_ = 0; mb_ < 17; ++mb_) { int mb = mb_; asm volatile("" : "+s"(mb)); f32x4 acc[2]; acc[0] = (f32x4){0.f, 0.f, 0.f, 0.f}; acc[1] = acc[0]; const int k = 16 * mb + fr;
                bf16x8 hc[4]; float yc[2][4];
#pragma unroll
                for (int s = 0; s < 4; ++s) { hc[s] = hn[s]; hn[s] = hn2[s]; }
#pragma unroll
                for (int nb = 0; nb < 2; ++nb)
#pragma unroll
                    for (int r = 0; r < 4; ++r) yc[nb][r] = yn[nb][r];
                { const int mn = mb + 2 < 17 ? mb + 2 : 16, m1 = mb + 1 < 17 ? mb + 1 : 16;
#pragma unroll
                  for (int s = 0; s < 4; ++s) hn2[s] = *(const GAS bf16x8*)(HS + (size_t)(16 * mn + fr) * 128 + 32 * s + 8 * fq);
                  if (dir == 1) {
#pragma unroll
                    for (int nb = 0; nb < 2; ++nb)
#pragma unroll
                        for (int r = 0; r < 4; ++r) yn[nb][r] = YF[(((size_t)b * 64 + g) * RPB + s5_jrow(1, 16 * (16 * m1 + 4 * fq + r) + 2 * w + nb)) * 16 + fr]; } }
#pragma unroll
                for (int s = 0; s < 12; ++s) { bf16x8 a;
                    if (s < 8) a = *(const LAS bf16x8*)(UL + s5_uoff(s5_jrow(dir, 16 * k + 2 * s + (fq >> 1))) + (fq & 1) * 16); else a = hc[s - 8];
                    acc[0] = __builtin_amdgcn_mfma_f32_16x16x32_bf16(a, bt[0][s], acc[0], 0, 0, 0); acc[1] = __builtin_amdgcn_mfma_f32_16x16x32_bf16(a, bt[1][s], acc[1], 0, 0, 0);
                    if (s == 3 || s == 7) asm volatile("" ::: "memory"); }
#pragma unroll
                for (int nb = 0; nb < 2; ++nb)
#pragma unroll
                    for (int r = 0; r < 4; ++r) { const int jr = s5_jrow(dir, 16 * (16 * mb + 4 * fq + r) + 2 * w + nb); const size_t o = ((size_t)b * RPB + jr) * 1024 + g * 16 + fr;
                        if (dir == 0) YF[(((size_t)b * 64 + g) * RPB + jr) * 16 + fr] = acc[nb][r];
                        else { const float u = bf2f(*(const LAS bf16*)(UL + s5_uoff(jr) + fr * 2)); GB[o] = (bf16)f2bf(gelu_tanh(acc[nb][r] + yc[nb][r] + dsk * u)); } } }
        }
        VM_WAIT(); __syncthreads();
    }
}
__device__ __forceinline__ void attn_unit(Ctx& F, int layer, int b, int h, size_t qrow, int seq) {
    att::attn_dense_body<att::bf16>((const att::bf16*)(WSP(bf16, WS_P) + qrow * NP + C_AQ + h * 128), (const att::bf16*)(WSP(bf16, WS_KN) + (size_t)b * RPB * 512 + (h >> 2) * 128),
        (const att::bf16*)(WSP(bf16, WS_VN) + (size_t)b * RPB * 512 + (h >> 2) * 128), WSP(bf16, WS_AT) + qrow * 2048 + h * 128, seq, (char*)(F.lds + RING_OFF), F.tid,
        NP, inp(F, I_AQG) + layer * 128, WSP(float, WS_ROPE), seq == TC ? -1 : (int)(qrow - (size_t)b * RPB) - TC);
    VM_WAIT(); __syncthreads();
    { const bf16* P = WSP(bf16, WS_P); const bf16* AT = WSP(bf16, WS_AT); bf16* AC = WSP(bf16, WS_ACAT);
#pragma unroll
      for (int q = 0; q < 8; ++q) { const int e = F.tid + 512 * q; const size_t r = qrow + (e >> 4); const int c8 = h * 128 + (e & 15) * 8;
        const v4u a = *(const GAS v4u*)(AT + r * 2048 + c8), g = *(const GAS v4u*)(P + r * NP + C_AZ + c8);
        v4u o; o.x = pk2(bflo(a.x) * bflo(g.x), bfhi(a.x) * bfhi(g.x)); o.y = pk2(bflo(a.y) * bflo(g.y), bfhi(a.y) * bfhi(g.y));
        o.z = pk2(bflo(a.z) * bflo(g.z), bfhi(a.z) * bfhi(g.z)); o.w = pk2(bflo(a.w) * bflo(g.w), bfhi(a.w) * bfhi(g.w));
        *(GAS v4u*)(AC + r * DM + 2048 + c8) = o; } }
}

__device__ __forceinline__ void ph_inproj_reduce(Ctx& F) {
    pg8::InProjOrder O; O.init(MROWS, NP, F.G, F.bid, 1, 1 << 30);
    const float* PT = WSP(float, WS_PARTP); bf16* P = WSP(bf16, WS_P); bf16* UB = WSP(bf16, WS_UB);
    for (int it = F.bid * NTHR + F.tid; it < 62 * 8192; it += F.G * NTHR) {
        const int e = it >> 13, rr = (it >> 5) & 255, c8 = (it & 31) * 8;
        pg8::Unit u; O.at(2816 + e, u);
        f32x4 v0 = {0.f, 0.f, 0.f, 0.f}, v1 = v0;
#pragma unroll
        for (int ks = 0; ks < 4; ++ks) { const float* pp = PT + ((size_t)(e * 4 + ks) * 256 + rr) * 256 + c8; v0 += *(const GAS f32x4*)pp; v1 += *(const GAS f32x4*)(pp + 4); }
        const int pn = u.pn; const int act = (pn >= 40 && pn < 88) ? 2 : (((pn >= 4 && pn < 8) || (pn >= 16 && pn < 20) || (pn >= 32 && pn < 40)) ? 1 : 0);
        if (act == 1) {
#pragma unroll
            for (int j = 0; j < 4; ++j) { v0[j] = siluf_(v0[j]); v1[j] = siluf_(v1[j]); } }
        else if (act == 2) {
#pragma unroll
            for (int j = 0; j < 4; ++j) { v0[j] = sigmoidf_(v0[j]); v1[j] = sigmoidf_(v1[j]); } }
        const v4u o = (v4u){pk2(v0[0], v0[1]), pk2(v0[2], v0[3]), pk2(v1[0], v1[1]), pk2(v1[2], v1[3])};
        const int row = u.pm * 256 + rr, col = pn * 256 + c8;
        if (pn < 4) { const int bb = u.pm / 17, jj = (u.pm % 17) * 256 + rr; *(GAS v4u*)(UB + (((size_t)bb * 64 + (col >> 4)) * RPB + jj) * 16 + (col & 15)) = o; }
        else *(GAS v4u*)(P + (size_t)row * NP + col) = o;
    }
}
#ifndef REP_PRO
#define REP_PRO 1
#endif
#ifndef REP_INPROJ
#define REP_INPROJ 1
#endif
#ifndef REP_PREP
#define REP_PREP 1
#endif
#ifndef REP_MIX
#define REP_MIX 1
#endif
#ifndef REP_S5
#define REP_S5 1
#endif
#ifndef REP_GSEQ
#define REP_GSEQ 1
#endif
#ifndef REP_ATT
#define REP_ATT 1
#endif
#ifndef REP_MERGE
#define REP_MERGE 1
#endif
#ifndef REP_NORM
#define REP_NORM 1
#endif
constexpr int ST_PRO = 0, ST_MODR = 1, ST_L0 = 2, ST_PER_L = 7, ST_FINAL = ST_L0 + 2 * ST_PER_L, NSTEPS = ST_FINAL + 1;
struct Args { const float* in[N_IN]; float* out; unsigned char* ws; int lo, hi, li, pad; };
__global__ void __launch_bounds__(NTHR, 2) fwd(Args args) {
    extern __shared__ __attribute__((aligned(16))) unsigned char lds[];
    Ctx F;
    F.lds = (LAS unsigned char*)lds;
    F.MISC = (volatile LAS unsigned*)(F.lds + MISC_OFF);
    F.tid = threadIdx.x; F.lane = F.tid & 63; F.wave = __builtin_amdgcn_readfirstlane(F.tid >> 6);
    F.G = gridDim.x; F.bid = blockIdx.x;
    F.ws = args.ws; F.out = args.out; F.ctl = (gu32*)(args.ws + WS_CTL);
    for (int u = F.tid; u < (LDS_BYTES - LDSCTL_OFF) / 4; u += NTHR) ((LAS unsigned*)(F.lds + LDSCTL_OFF))[u] = 0u;
    __syncthreads();
    if (F.tid < N_IN) *(LAS unsigned long long*)(F.lds + INTAB_OFF + 8 * F.tid) = (unsigned long long)args.in[F.tid];
    __syncthreads();
    XcdBarrier bar = xcd_barrier_post((unsigned*)(F.ctl + CW_BAR) + args.li * XCD_BAR_WORDS, F.MISC + 8);
    const int lo = args.lo, hi = args.hi; const int wave0 = F.wave;
#define IN(k) (lo <= (k) && (k) < hi)
#define REFRESH() do { int w_ = wave0; asm volatile("" : "+s"(w_)); int l_; asm volatile("v_mbcnt_lo_u32_b32 %0, -1, 0\n\tv_mbcnt_hi_u32_b32 %0, -1, %0" : "=v"(l_)); F.wave = w_; F.lane = l_; F.tid = w_ * 64 + l_; } while (0)
#define SEAM(k) do { if (IN(k) && IN((k) + 1)) xcd_barrier(bar); } while (0)

    if (IN(ST_PRO)) for (int rep_ = 0; rep_ < REP_PRO; ++rep_) { REFRESH();
#ifndef DIS_PRO
 ph_rope_table(F);
            { const int NL1 = (F.G == 256) ? 322 : 0, NMEM = 384 + TJ_JOBS + NL1, NJ = NMEM + 256;
              for (;;) {
                __syncthreads();
                if (F.tid == 0) F.MISC[16] = __hip_atomic_fetch_add((unsigned*)(F.ctl + CW_TQ + 64 * (5 + 8 * rep_)), 1u, RLX_AGENT);
                __syncthreads();
                const int j = (int)F.MISC[16];
                if (j >= NJ) break;
                REFRESH();
                const int stride = NJ / 256, s = j / stride;
                if (j % stride == 0 && s < 256) { s5_mats_item(F, s); continue; }
                const int m = j - (s + 1 < 256 ? s + 1 : 256);
                if (m < 384) mod_partial_item(F, m);
                else if (m < 384 + TJ_JOBS) transpose_job(F, 0, m - 384);
                else transpose_job(F, 1, m - 384 - TJ_JOBS);
              } }
#endif
 }
    SEAM(ST_PRO);
    if (IN(ST_MODR)) { REFRESH(); ph_mod_reduce(F); }
    SEAM(ST_MODR);
#pragma unroll 1
    for (int l = 0; l < 2; ++l) {
        const int sb = ST_L0 + ST_PER_L * l;
        if (IN(sb + 0)) for (int rep_ = 0; rep_ < REP_NORM; ++rep_) { REFRESH();
#ifndef DIS_NORM
 ph_norm(F, l, F.G == 256);
#endif
 }
        SEAM(sb + 0);
        if (IN(sb + 1)) for (int rep_ = 0; rep_ < REP_INPROJ; ++rep_) { REFRESH();
            pg8::Gemm g{WSP(bf16, WS_H), WSP(bf16, WS_WIN) + (size_t)l * NP * DM, MROWS, NP, DM, DM, DM}; const bool ksplit = (l == 1 && F.G == 256 && lo == 0 && hi == NSTEPS);
            pg8::InProjOrder S; S.init(MROWS, NP, F.G, F.bid, l, ksplit ? 11 : (1 << 30));
            pg8::EpiInProj E{WSP(bf16, WS_P), WSP(bf16, WS_UB)};
#ifndef DIS_G1
            pg8::gemm_phase<pg8::EpiInProj, pg8::InProjOrder, true, true>(F.lds + RING_OFF, g, S, E, F.tid);
#endif
            if (ksplit) { REFRESH();
                pg8::Gemm g2{WSP(bf16, WS_H), WSP(bf16, WS_WIN) + (size_t)l * NP * DM, MROWS, NP, 1024, DM, DM}; pg8::InProjSplitOrder S2; S2.init(MROWS, NP, F.G, F.bid);
                pg8::EpiPartial E2{WSP(float, WS_PARTP)};
                pg8::gemm_phase<pg8::EpiPartial, pg8::InProjSplitOrder, true, true>(F.lds + RING_OFF, g2, S2, E2, F.tid);
                xcd_barrier(bar); REFRESH(); ph_inproj_reduce(F); }
        }
        SEAM(sb + 1);
        if (IN(sb + 2)) for (int rep_ = 0; rep_ < REP_PREP; ++rep_) { REFRESH();
            for (;;) {
                __syncthreads();
                if (F.tid == 0) F.MISC[16] = __hip_atomic_fetch_add((unsigned*)(F.ctl + CW_PQ + 64 * (l + 2 * rep_)), 1u, RLX_AGENT);
                __syncthreads();
                const int j = (int)F.MISC[16];
                if (j >= NB * GNCH + MROWS / 32) break;
                REFRESH();
                if (j < NB * GNCH) gla_prep_item(F, l, j); else attn_prep_rows(F, l, (j - NB * GNCH) * 32, (j - NB * GNCH) * 32 + 32);
            }
 }
        SEAM(sb + 2);
        if (IN(sb + 3)) for (int rep_ = 0; rep_ < REP_MIX; ++rep_) { REFRESH();
            const int n_ctx = (l == 0) ? 32 : 0, n_jobs = 160 + n_ctx + 512;
            for (;;) {
                __syncthreads();
                if (F.tid == 0) F.MISC[16] = __hip_atomic_fetch_add((unsigned*)(F.ctl + CW_QUEUE + 64 * (l + 2 * rep_)), 1u, RLX_AGENT);
                __syncthreads();
                const int j = (int)F.MISC[16];
                if (j >= n_jobs) break;
                REFRESH();
                if (j < 32) {
#ifndef DIS_GSEQ
                    for (int rs_ = 0; rs_ < REP_GSEQ; ++rs_) gla_seq_job(F, l, j);
#endif
                } else if (j < 160) {
#ifndef DIS_S5
                    for (int rs_ = 0; rs_ < REP_S5; ++rs_) s5_job(F, l, j - 32);
#endif
                } else { const int u = j - 160; const bool isc = u >= 512; const int uu = isc ? u - 512 : u;
                    const int b = isc ? (uu >> 4) : (uu >> 8), h = isc ? (uu & 15) : ((uu >> 4) & 15), qb = uu & 15;
#ifndef DIS_ATT
                    for (int ra_ = 0; ra_ < REP_ATT; ++ra_) { if (ra_) { __syncthreads(); REFRESH(); } attn_unit(F, l, b, h, (size_t)b * RPB + (isc ? 0 : TC + qb * 256), isc ? TC : RPB); }
#endif
                }
            }
#if REP_MIX > 1
            if (rep_ + 1 < REP_MIX) xcd_barrier(bar);
#endif
        }
        SEAM(sb + 3);
        if (IN(sb + 4)) for (int rep_ = 0; rep_ < REP_MERGE; ++rep_) { REFRESH();
#ifndef DIS_GPOST
            ph_gla_post(F, l, (l == 1 && F.G == 256) ? 128 : 0);
#endif
            pg8::Gemm g{WSP(bf16, WS_GB), WSP(bf16, WS_WGLU) + (size_t)l * 1024 * 1024, MROWS, 1024, 1024, 1024, 1024}; pg8::RowOrder S; S.init(MROWS, 1024, F.G, F.bid, l);
            pg8::EpiGlu E{WSP(bf16, WS_GB), WSP(bf16, WS_P), WSP(bf16, WS_ACAT)};
#ifndef DIS_G2
            pg8::gemm_phase<pg8::EpiGlu, pg8::RowOrder, true, true>(F.lds + RING_OFF, g, S, E, F.tid);
#endif
            if (l == 0) { REFRESH(); transposes_fill(F, (unsigned*)(F.ctl + CW_TQ + 64 * (0 + 8 * rep_)), 322, 552); }
        }
        SEAM(sb + 4);
        if (IN(sb + 5)) for (int rep_ = 0; rep_ < REP_MERGE; ++rep_) { REFRESH();
            pg8::RowOrder S; S.init(MROWS, DM, F.G, F.bid, l);
            pg8::Gemm g{WSP(bf16, WS_ACAT), WSP(bf16, WS_WCAT) + (size_t)l * DM * DM, MROWS, DM, DM, DM, DM};
            pg8::EpiProjCat E{WSP(bf16, WS_P), WSP(bf16, WS_MRG)};
#ifndef DIS_G3
            pg8::gemm_phase<pg8::EpiProjCat, pg8::RowOrder, true, true>(F.lds + RING_OFF, g, S, E, F.tid);
#endif
            if (l == 0) { REFRESH(); transposes_fill(F, (unsigned*)(F.ctl + CW_TQ + 64 * (1 + 8 * rep_)), 552, 1952); }
        }
        SEAM(sb + 5);
        if (IN(sb + 6)) for (int rep_ = 0; rep_ < REP_MERGE; ++rep_) { REFRESH();
            const bool ctxsplit = (l == 0 && F.G == 256);
            pg8::Gemm g{WSP(bf16, WS_MRG), WSP(bf16, WS_WO) + (size_t)l * DM * DM, MROWS, DM, DM, DM, DM}; pg8::RowOrder S; S.init(MROWS, DM, F.G, F.bid, (l == 1 || ctxsplit) ? 1 : 0);
            pg8::EpiOut E{inp(F, I_X), inp(F, I_CTX), WSP(float, WS_X1), F.out, WSP(float, WS_MOD) + (size_t)l * 3 * 12288, l};
#ifndef DIS_G4
            pg8::gemm_phase<pg8::EpiOut, pg8::RowOrder, true, true>(F.lds + RING_OFF, g, S, E, F.tid);
#endif
            if (ctxsplit) { REFRESH();
                pg8::Gemm g2{WSP(bf16, WS_MRG), WSP(bf16, WS_WO), MROWS, DM, 512, DM, DM}; pg8::CtxSplitOrder S2; S2.init(F.G, F.bid);
                pg8::EpiOutCtxPartial E2{WSP(float, WS_PART)};
                pg8::gemm_phase<pg8::EpiOutCtxPartial, pg8::CtxSplitOrder, true, true>(F.lds + RING_OFF, g2, S2, E2, F.tid); }
            if (l == 0 && !ctxsplit) { REFRESH(); transposes_fill(F, (unsigned*)(F.ctl + CW_TQ + 64 * (4 + 8 * rep_)), 0, 322); }
        }
        SEAM(sb + 6);
    }
    if (IN(ST_FINAL)) { REFRESH();
#ifndef DIS_FINAL
 ph_final(F);
#endif
 }
#undef IN
#undef REFRESH
#undef SEAM
}

#ifndef MK_ONE_LAUNCH
#define MK_ONE_LAUNCH 1
#endif
extern "C" void kernel_launch(void* const* d_in, const int* in_sizes, int n_in, void* d_out, int out_size, void* d_ws, size_t ws_size, hipStream_t stream) {
    static int grid = 0;
    if (grid == 0) {
        if (n_in != N_IN || in_sizes[0] != NB * TL * DM || out_size != NB * TL * DM || ws_size < WS_END) {
            fprintf(stderr, "kernel_launch: shape mismatch: n_in %d in0 %d out %d ws %zu (need %zu); nothing launched\n", n_in, n_in > 0 ? in_sizes[0] : -1, out_size, ws_size, (size_t)WS_END); grid = -1; return; }
        int dev = 0, cus = 0, per_cu = 0;
        if (hipGetDevice(&dev) != hipSuccess || hipDeviceGetAttribute(&cus, hipDeviceAttributeMultiprocessorCount, dev) != hipSuccess) { fprintf(stderr, "kernel_launch: device query failed\n"); grid = -1; return; }
        if (hipFuncSetAttribute((const void*)fwd, hipFuncAttributeMaxDynamicSharedMemorySize, LDS_BYTES) != hipSuccess) { fprintf(stderr, "kernel_launch: hipFuncSetAttribute failed\n"); grid = -1; return; }
        if (hipOccupancyMaxActiveBlocksPerMultiprocessor(&per_cu, (const void*)fwd, NTHR, LDS_BYTES) != hipSuccess || per_cu < 1)
            fprintf(stderr, "kernel_launch: note: occupancy query reports %d workgroups per CU\n", per_cu);
        (void)hipGetLastError();
        grid = cus;
    }
    if (grid < 0) return;
    if (hipMemsetAsync((char*)d_ws + WS_CTL, 0, CTL_ZERO_BYTES, stream) != hipSuccess) { fprintf(stderr, "kernel_launch: memset failed\n"); return; }
    Args a{};
    for (int i = 0; i < N_IN; ++i) a.in[i] = (const float*)d_in[i];
    a.out = (float*)d_out; a.ws = (unsigned char*)d_ws; a.pad = 0;
#if MK_ONE_LAUNCH
    a.lo = 0; a.hi = NSTEPS; a.li = 0;
    hipLaunchKernelGGL(fwd, dim3(grid), dim3(NTHR), LDS_BYTES, stream, a);
#else
    for (int s = 0; s < NSTEPS; ++s) { a.lo = s; a.hi = s + 1; a.li = s; hipLaunchKernelGGL(fwd, dim3(grid), dim3(NTHR), LDS_BYTES, stream, a); }
#endif
    const hipError_t le = hipPeekAtLastError();
    if (le != hipSuccess) fprintf(stderr, "kernel_launch: launch failed: %s\n", hipGetErrorName(le));
}
```

```cpp
#include <hip/hip_runtime.h>
#include <hip/hip_bf16.h>
#include <cstdio>
#include <cstdint>

#define GAS __attribute__((address_space(1)))
#define LAS __attribute__((address_space(3)))
typedef unsigned short bf16;
typedef unsigned v4u __attribute__((ext_vector_type(4)));
typedef unsigned v2u __attribute__((ext_vector_type(2)));
typedef float f32x4 __attribute__((ext_vector_type(4)));
typedef float f32x2 __attribute__((ext_vector_type(2)));
typedef short bf16x8 __attribute__((ext_vector_type(8)));
typedef short bf16x4 __attribute__((ext_vector_type(4)));
typedef GAS unsigned gu32;

constexpr int DM = 4096, NB = 2, TL = 4096, TC = 256, RPB = TC + TL  , MROWS = NB * RPB  ;
constexpr int NIN = 22560, NP = 22784  ;
constexpr int C_SU = 0, C_SZ = 1024, C_GQ = 2048, C_GK = 2560, C_GV = 3072, C_GZ = 4096, C_AQ = 5120, C_AK = 7168, C_AV = 7680, C_AZ = 8192, C_MG = 10240, C_LR = 22528;
constexpr int SSM_W = 1024, GLA_KW = 512, GLA_VW = 1024, ATT_QW = 2048, ATT_KVW = 512;
constexpr float EPS = 1e-6f;
constexpr int NWAVES = 8, NTHR = 512;
constexpr int GCH = 32  , GNCH = RPB / GCH  , GNCTX = TC / GCH  ;
constexpr int SCH = 16  , SNCH = RPB / SCH  ;

enum { I_X = 0, I_C, I_CTX, I_CCTX, I_NORMG, I_WMOD, I_BMOD, I_WIN, I_LAMRE, I_LAMIM, I_LOGDT, I_BRE, I_BIM, I_CRE, I_CIM, I_SSMD, I_WGLU, I_GWA, I_GBA, I_GNORM,
       I_AQG, I_AKG, I_WPS, I_WPG, I_WPA, I_WOUT, I_FINALG, N_IN };

constexpr size_t al256(size_t x) { return (x + 255) / 256 * 256; }
constexpr size_t WS_CTL = 0, CTL_ZERO_BYTES = 1u << 20;
constexpr size_t WS_MODP = WS_CTL + CTL_ZERO_BYTES;
constexpr size_t WS_MOD = WS_MODP + al256((size_t)2 * 32 * 3 * 12288 * 4);
constexpr size_t WS_ROPE = WS_MOD + al256((size_t)2 * 3 * 12288 * 4);
constexpr size_t WS_WIN = WS_ROPE + al256((size_t)2 * 64 * 32 * 4);
constexpr size_t WS_WGLU = WS_WIN + al256((size_t)2 * NP * DM * 2);
constexpr size_t WS_WPS = WS_WGLU + al256((size_t)2 * 1024 * 1024 * 2);
constexpr size_t WS_WPG = WS_WPS + al256((size_t)2 * 4096 * 1024 * 2);
constexpr size_t WS_WPA = WS_WPG + al256((size_t)2 * 4096 * 1024 * 2);
constexpr size_t WS_WO = WS_WPA + al256((size_t)2 * 4096 * 2048 * 2);
constexpr size_t WS_TG = WS_WO + al256((size_t)2 * 4096 * 4096 * 2);
constexpr size_t WS_WT = WS_TG + al256((size_t)2 * 2 * 64 * 256 * 384 * 2);
constexpr size_t WS_L16 = WS_WT + al256((size_t)2 * 2 * 64 * 128 * 256 * 2);
constexpr size_t WS_H = WS_L16 + al256((size_t)2 * 2 * 64 * 64 * 2 * 4);
constexpr size_t WS_P = WS_H + al256((size_t)MROWS * DM * 2);
constexpr size_t WS_X1 = WS_P + al256((size_t)MROWS * NP * 2);
constexpr size_t WS_QN = WS_X1 + al256((size_t)MROWS * DM * 4);
constexpr size_t WS_KN = WS_QN + al256((size_t)MROWS * 2048 * 2);
constexpr size_t WS_E = WS_KN + al256((size_t)MROWS * 512 * 2);
constexpr size_t WS_HS = WS_E + al256((size_t)128 * SNCH * 128 * 4);
constexpr size_t WS_YF = WS_HS + al256((size_t)128 * SNCH * 128 * 2);
constexpr size_t WS_GB = WS_YF + al256((size_t)MROWS * 1024 * 4);
constexpr size_t WS_SB = WS_GB + al256((size_t)MROWS * 1024 * 2);
constexpr size_t WS_GL = WS_SB + al256((size_t)MROWS * 1024 * 2);
constexpr size_t WS_AT = WS_GL + al256((size_t)MROWS * 1024 * 2);
constexpr size_t WS_QH = WS_AT + al256((size_t)MROWS * 2048 * 2);
constexpr size_t WS_KHT = WS_QH + al256((size_t)2 * MROWS * 512 * 2);
constexpr size_t WS_AM = WS_KHT + al256((size_t)2 * MROWS * 512 * 2);
constexpr size_t WS_VT = WS_AM + al256((size_t)2 * 272 * 8 * 32 * 32 * 2);
constexpr size_t WS_DEC = WS_VT + al256((size_t)272 * 8 * 128 * 32 * 2);
constexpr size_t WS_GO = WS_DEC + al256((size_t)2 * 272 * 512 * 4);
constexpr size_t WS_MACC = WS_GO + al256((size_t)2 * MROWS * 1024 * 4);
constexpr size_t WS_MRG = WS_MACC + al256((size_t)MROWS * DM * 4);
constexpr size_t WS_VN = WS_MRG + al256((size_t)MROWS * DM * 2);
constexpr size_t WS_ATG = WS_VN + al256((size_t)MROWS * 512 * 2);
constexpr size_t WS_ACAT = WS_ATG + al256((size_t)MROWS * 2048 * 2);
constexpr size_t WS_WCAT = WS_ACAT + al256((size_t)MROWS * DM * 2);
constexpr size_t WS_PART = WS_WCAT + al256((size_t)2 * DM * DM * 2);
constexpr size_t WS_UB = WS_PART + al256((size_t)8 * 512 * DM * 4);
constexpr size_t WS_PARTP = WS_UB + al256((size_t)MROWS * 1024 * 2);
constexpr size_t WS_END = WS_PARTP + al256((size_t)248 * 65536 * 4);

constexpr int CW_TMO = 0, CW_CODE = 1, CW_QUEUE = 1024, CW_PQ = 1536, CW_TQ = 2048, CW_BAR = 4096, CW_MQ = 131072  ;

constexpr int RING_OFF = 0, RING_BYTES = 147456;
constexpr int LDSCTL_OFF = RING_BYTES, MISC_OFF = LDSCTL_OFF + 320, INTAB_OFF = LDSCTL_OFF + 512;
constexpr int LDS_BYTES = 148480;

#define RLX_AGENT __ATOMIC_RELAXED, __HIP_MEMORY_SCOPE_AGENT
#define LDS_WAIT() asm volatile("s_waitcnt lgkmcnt(0)" ::: "memory")
#define VM_WAIT() asm volatile("s_waitcnt vmcnt(0)" ::: "memory")
__device__ __forceinline__ unsigned f2bf(float f) { unsigned u = __builtin_bit_cast(unsigned, f); return (u + 0x7fffu + ((u >> 16) & 1u)) >> 16; }
__device__ __forceinline__ unsigned pk2(float lo, float hi) { return f2bf(lo) | (f2bf(hi) << 16); }
__device__ __forceinline__ float bf2f(unsigned short b) { return __builtin_bit_cast(float, (unsigned)b << 16); }
__device__ __forceinline__ float bflo(unsigned w) { return __builtin_bit_cast(float, w << 16); }
__device__ __forceinline__ float bfhi(unsigned w) { return __builtin_bit_cast(float, w & 0xffff0000u); }
__device__ __forceinline__ float sigmoidf_(float x) { return __builtin_amdgcn_rcpf(1.0f + __builtin_amdgcn_exp2f(-1.4426950408889634f * x)); }
__device__ __forceinline__ float siluf_(float x) { return x * __builtin_amdgcn_rcpf(1.0f + __builtin_amdgcn_exp2f(-1.4426950408889634f * x)); }
__device__ __forceinline__ float gelu_tanh(float x) {
    const float u = 1.5957691216057308f * (x + 0.044715f * x * x * x); return x * __builtin_amdgcn_rcpf(1.0f + __builtin_amdgcn_exp2f(-1.4426950408889634f * u)); }
__device__ __forceinline__ float wave_sum(float v) {
#pragma unroll
    for (int o = 1; o < 64; o <<= 1) v += __shfl_xor(v, o);
    return v;
}
namespace pg8 {
#define PG8_LAS __attribute__((address_space(3)))
typedef unsigned short bf16_t;
typedef unsigned u32x4 __attribute__((ext_vector_type(4)));
constexpr int BM = 256, BK = 64, HALF = 128, HTB = HALF * BK * 2  , STAGE_BYTES = 8 * HTB, NXCD = 8, WGM = 8;

__host__ __device__ __forceinline__ int lds_byte(int r, int c) { const int st = (r >> 4) * 2 + (c >> 5), rr = r & 15, cc = c & 31, ob = rr * 64 + cc * 2; return st * 1024 + (ob ^ (((ob >> 9) & 1) << 5)); }
__host__ __device__ __forceinline__ void stage_rc(int b, int& R, int& C) { const int st = b / 1024, sb = b % 1024, swz = sb ^ (((sb >> 9) & 1) << 5); R = (st >> 1) * 16 + swz / 64; C = (st & 1) * 32 + (swz % 64) / 2; }
__host__ __device__ __forceinline__ int perm32(int rho) { const int n = rho >> 4, i = rho & 15; return 8 * (i >> 2) + 4 * n + (i & 3); }

struct Unit { int pm, pn, ko, aux; };
struct Gemm { const bf16_t* A; const bf16_t* Bt; int M, N, K, lda, ldb; };

struct StaticOrder {
    int nM, nN, nwg, G, c;
    __host__ __device__ void init(int M, int N, int G_, int c_) { nM = M / BM; nN = N / BM; nwg = nM * nN; G = G_; c = c_; }
    __host__ __device__ bool next(int i, Unit& u) const { return at((long)i * G + c, u); }
    __host__ __device__ bool at(long L, Unit& u) const {
        if (L >= nwg) return false;
        int wgid = (int)L; { const int q = nwg / NXCD, r = nwg % NXCD, xcd = wgid % NXCD, off = wgid / NXCD; wgid = (xcd < r ? xcd * (q + 1) : r * (q + 1) + (xcd - r) * q) + off; }
        const int nig = WGM * nN, gid = wgid / nig, fm = gid * WGM, gsz = (nM - fm) < WGM ? (nM - fm) : WGM;
        u.pm = fm + ((wgid % nig) % gsz); u.pn = (wgid % nig) / gsz; u.ko = 0; u.aux = 0; return true;
    }
    __device__ __forceinline__ void a_ready(const Unit&) const {}
    __device__ __forceinline__ void done(const Unit&) const {}
};

struct RowOrder {
    StaticOrder b; int lat;
    __host__ __device__ void init(int M, int N, int G_, int c_, int lat_) { lat = lat_; b.init(lat_ ? M - 512 : M, N, G_, c_); }
    __host__ __device__ bool next(int i, Unit& u) const { if (!b.next(i, u)) return false; if (lat) u.pm += 1 + (u.pm >= 16 ? 1 : 0); return true; }
    __device__ __forceinline__ void a_ready(const Unit&) const {}
    __device__ __forceinline__ void done(const Unit&) const {}
};

struct InProjOrder {
    StaticOrder b; int lat, G, c, imax;
    __host__ __device__ void init(int M, int N, int G_, int c_, int lat_, int imax_) { lat = lat_; G = G_; c = c_; imax = imax_; b.init(lat_ ? M - 512 : M, N, G_, c_); }
    __host__ __device__ bool next(int i, Unit& u) const { if (i >= imax) return false; return at((long)i * G + c, u); }
    __host__ __device__ bool at(long L, Unit& u) const {
        if (!lat) return b.at(L, u);
        if (b.at(L, u)) { u.pm += 1 + (u.pm >= 16 ? 1 : 0); return true; }
        const int e = (int)(L - b.nwg); if (e >= 30) return false;
        const int t = e % 15; u.pm = (e / 15) * 17; u.pn = t < 4 ? t : (t < 10 ? t + 6 : (t < 14 ? t + 18 : 88)); u.ko = 0; u.aux = 0; return true;
    }
    __device__ __forceinline__ void a_ready(const Unit&) const {}
    __device__ __forceinline__ void done(const Unit&) const {}
};

struct InProjSplitOrder {
    InProjOrder o; int G, c;
    __host__ __device__ void init(int M, int N, int G_, int c_) { G = G_; c = c_; o.init(M, N, G_, c_, 1, 1 << 30); }
    __host__ __device__ bool next(int i, Unit& u) const { const int s = i * G + c; if (s >= 248) return false; if (!o.at(2816 + (s >> 2), u)) return false; u.ko = (s & 3) * 1024; u.aux = s; return true; }
    __device__ __forceinline__ void a_ready(const Unit&) const {}
    __device__ __forceinline__ void done(const Unit&) const {}
};
struct EpiPartial {
    static constexpr bool KHOOK = false;
    static constexpr bool PERM = false, AFTER_DRAIN = false;
    float* PART;
    __device__ __forceinline__ void operator()(const f32x4 (&acc)[2][2][4][2], const Unit& u, int wr, int wc, int fr, int fq) const {
        float* dst = PART + (size_t)u.aux * 65536; const int rr0 = wr * 64 + fr, col0 = wc * 32 + 4 * fq;
#pragma unroll
        for (int ai = 0; ai < 2; ++ai)
#pragma unroll
            for (int m = 0; m < 4; ++m) { const int off = (rr0 + ai * HALF + m * 16) * 256 + col0;
#pragma unroll
                for (int bj = 0; bj < 2; ++bj)
#pragma unroll
                    for (int n = 0; n < 2; ++n) *(f32x4*)(dst + off + bj * HALF + n * 16) = acc[ai][bj][m][n]; }
    }
};

struct CtxSplitOrder {
    int G, c;
    __host__ __device__ void init(int G_, int c_) { G = G_; c = c_; }
    __host__ __device__ bool next(int i, Unit& u) const { const int L = i * G + c; if (L >= 256) return false; u.pm = (L >> 7) * 17; u.pn = (L >> 3) & 15; u.ko = (L & 7) * 512; u.aux = 0; return true; }
    __device__ __forceinline__ void a_ready(const Unit&) const {}
    __device__ __forceinline__ void done(const Unit&) const {}
};

__device__ __forceinline__ unsigned cvt_pk_bf16(float lo, float hi) { unsigned r; asm volatile("v_cvt_pk_bf16_f32 %0, %1, %2" : "=v"(r) : "v"(lo), "v"(hi)); return r; }
__device__ __forceinline__ u32x4 pack8(const f32x4 v0, const f32x4 v1) { u32x4 w; w.x = cvt_pk_bf16(v0[0], v0[1]); w.y = cvt_pk_bf16(v0[2], v0[3]); w.z = cvt_pk_bf16(v1[0], v1[1]); w.w = cvt_pk_bf16(v1[2], v1[3]); return w; }
__device__ __forceinline__ void unpack8(const u32x4 w, f32x4& v0, f32x4& v1) { v0 = (f32x4){bflo(w.x), bfhi(w.x), bflo(w.y), bfhi(w.y)}; v1 = (f32x4){bflo(w.z), bfhi(w.z), bflo(w.w), bfhi(w.w)}; }

struct EpiInProj {
    static constexpr bool KHOOK = false;
    static constexpr bool PERM = true, AFTER_DRAIN = false;
    bf16_t* P; bf16_t* UB;
    __device__ __forceinline__ void operator()(const f32x4 (&acc)[2][2][4][2], const Unit& u, int wr, int wc, int fr, int fq) const {
        const int pn = u.pn;
        const int act = (pn >= 40 && pn < 88) ? 2 : (((pn >= 4 && pn < 8) || (pn >= 16 && pn < 20) || (pn >= 32 && pn < 40)) ? 1 : 0);
        const int row0 = u.pm * BM + wr * 64 + fr, col0 = pn * BM + wc * 32 + 8 * fq;
#pragma unroll
        for (int ai = 0; ai < 2; ++ai)
#pragma unroll
            for (int m = 0; m < 4; ++m) { bf16_t* rowp = P + (size_t)(row0 + ai * HALF + m * 16) * NP + col0;
                if (pn < 4) {
                    const int bb = u.pm / 17, jj = (u.pm % 17) * BM + wr * 64 + fr + ai * HALF + m * 16;
#pragma unroll
                    for (int bj = 0; bj < 2; ++bj) { const int c = col0 + bj * HALF;
                        *(u32x4*)(UB + (((size_t)bb * 64 + (c >> 4)) * RPB + jj) * 16 + (c & 15)) = pack8(acc[ai][bj][m][0], acc[ai][bj][m][1]); }
                    continue; }
#pragma unroll
                for (int bj = 0; bj < 2; ++bj) { f32x4 v0 = acc[ai][bj][m][0], v1 = acc[ai][bj][m][1];
                    if (act == 1) {
#pragma unroll
                        for (int j = 0; j < 4; ++j) { v0[j] = siluf_(v0[j]); v1[j] = siluf_(v1[j]); } }
                    else if (act == 2) {
#pragma unroll
                        for (int j = 0; j < 4; ++j) { v0[j] = sigmoidf_(v0[j]); v1[j] = sigmoidf_(v1[j]); } }
                    *(u32x4*)(rowp + bj * HALF) = pack8(v0, v1); } }
    }
};
struct EpiGlu {
    static constexpr bool KHOOK = false;
    static constexpr bool PERM = true, AFTER_DRAIN = false;
    const bf16_t* GBp; const bf16_t* P; bf16_t* SBp;
    __device__ __forceinline__ void operator()(const f32x4 (&acc)[2][2][4][2], const Unit& u, int wr, int wc, int fr, int fq) const {
        const int row0 = u.pm * BM + wr * 64 + fr, col0 = u.pn * BM + wc * 32 + 8 * fq;
#pragma unroll
        for (int ai = 0; ai < 2; ++ai)
#pragma unroll
            for (int m = 0; m < 4; ++m) { const size_t row = (size_t)(row0 + ai * HALF + m * 16);
#pragma unroll
                for (int bj = 0; bj < 2; ++bj) { const int col = col0 + bj * HALF;
                    f32x4 g0, g1, z0, z1; unpack8(*(const u32x4*)(GBp + row * 1024 + col), g0, g1); unpack8(*(const u32x4*)(P + row * NP + C_SZ + col), z0, z1);
                    f32x4 v0 = acc[ai][bj][m][0], v1 = acc[ai][bj][m][1];
#pragma unroll
                    for (int j = 0; j < 4; ++j) { v0[j] = g0[j] * sigmoidf_(v0[j]) * z0[j]; v1[j] = g1[j] * sigmoidf_(v1[j]) * z1[j]; }
                    *(u32x4*)(SBp + row * DM + col) = pack8(v0, v1); } }
    }
};
struct EpiProjCat {
    static constexpr bool KHOOK = true;
    static constexpr bool PERM = true, AFTER_DRAIN = false;
    const bf16_t* P; bf16_t* MRG;
    __device__ __forceinline__ void khook(f32x4 (&acc)[2][2][4][2], const Unit& u, int t, int wr, int wc, int fr, int fq) const {
        const int gn = C_MG + (t == 16 ? 0 : 4096);
        int fr_ = fr, fq_ = fq; asm volatile("" : "+v"(fr_), "+v"(fq_));
        const int row0 = u.pm * BM + wr * 64 + fr_, col0 = u.pn * BM + wc * 32 + 8 * fq_;
#pragma unroll
        for (int ai = 0; ai < 2; ++ai)
#pragma unroll
            for (int mp = 0; mp < 2; ++mp) {
                u32x4 gnum[2][2], gden[2][2];
#pragma unroll
                for (int mm = 0; mm < 2; ++mm)
#pragma unroll
                    for (int bj = 0; bj < 2; ++bj) { const bf16_t* gp = P + (size_t)(row0 + ai * HALF + (2 * mp + mm) * 16) * NP + gn + col0 + bj * HALF; gnum[mm][bj] = *(const u32x4*)gp; gden[mm][bj] = *(const u32x4*)(gp + 4096); }
#pragma unroll
                for (int mm = 0; mm < 2; ++mm)
#pragma unroll
                    for (int bj = 0; bj < 2; ++bj) { const int m = 2 * mp + mm; f32x4 n0, n1, d0, d1; unpack8(gnum[mm][bj], n0, n1); unpack8(gden[mm][bj], d0, d1);
#pragma unroll
                        for (int j = 0; j < 4; ++j) { acc[ai][bj][m][0][j] *= n0[j] * __builtin_amdgcn_rcpf(d0[j]); acc[ai][bj][m][1][j] *= n1[j] * __builtin_amdgcn_rcpf(d1[j]); } }
                asm volatile("" ::: "memory");
            }
    }
    __device__ __forceinline__ void operator()(const f32x4 (&acc)[2][2][4][2], const Unit& u, int wr, int wc, int fr, int fq) const {
        const int row0 = u.pm * BM + wr * 64 + fr, col0 = u.pn * BM + wc * 32 + 8 * fq;
#pragma unroll
        for (int ai = 0; ai < 2; ++ai)
#pragma unroll
            for (int m = 0; m < 4; ++m) { const size_t row = (size_t)(row0 + ai * HALF + m * 16);
#pragma unroll
                for (int bj = 0; bj < 2; ++bj) { const int col = col0 + bj * HALF;
                    f32x4 g0, g1; unpack8(*(const u32x4*)(P + row * NP + C_MG + 8192 + col), g0, g1);
                    *(u32x4*)(MRG + row * DM + col) = pack8(acc[ai][bj][m][0] * g0, acc[ai][bj][m][1] * g1); } }
    }
};
struct EpiOut {
    static constexpr bool KHOOK = false;
    static constexpr bool PERM = false, AFTER_DRAIN = false;
    const float* xin; const float* cin; float* X1; float* out; const float* MODl; int layer;
    __device__ __forceinline__ void operator()(const f32x4 (&acc)[2][2][4][2], const Unit& u, int wr, int wc, int fr, int fq) const {
        const int b = u.pm / 17, jt = u.pm % 17; const bool isctx = (jt == 0);
        if (layer == 1 && isctx) return;
        const float* src; float* dst;
        if (layer == 0) { src = isctx ? cin + (size_t)b * TC * DM : xin + ((size_t)b * TL + (size_t)(jt - 1) * 256) * DM; dst = X1 + (size_t)u.pm * 256 * DM; }
        else { src = X1 + (size_t)u.pm * 256 * DM; dst = out + ((size_t)b * TL + (size_t)(jt - 1) * 256) * DM; }
        const float* gv = MODl + (size_t)(isctx ? 2 : b) * 12288 + 8192;
        const int rr0 = wr * 64 + fr, col0 = u.pn * BM + wc * 32 + 4 * fq;
        f32x4 gt[2][2];
#pragma unroll
        for (int bj = 0; bj < 2; ++bj)
#pragma unroll
            for (int n = 0; n < 2; ++n) gt[bj][n] = *(const f32x4*)(gv + col0 + bj * HALF + n * 16);
#pragma unroll
        for (int ai = 0; ai < 2; ++ai)
#pragma unroll
            for (int m = 0; m < 4; ++m) { const size_t off = (size_t)(rr0 + ai * HALF + m * 16) * DM + col0;
#pragma unroll
                for (int bj = 0; bj < 2; ++bj)
#pragma unroll
                    for (int n = 0; n < 2; ++n) { const f32x4 xo = *(const f32x4*)(src + off + bj * HALF + n * 16);
                        *(f32x4*)(dst + off + bj * HALF + n * 16) = xo + gt[bj][n] * acc[ai][bj][m][n]; } }
    }
};


struct EpiOutCtxPartial {
    static constexpr bool KHOOK = false;
    static constexpr bool PERM = false, AFTER_DRAIN = false;
    float* PART;
    __device__ __forceinline__ void operator()(const f32x4 (&acc)[2][2][4][2], const Unit& u, int wr, int wc, int fr, int fq) const {
        float* dst = PART + ((size_t)(u.ko >> 9) * 512 + (size_t)(u.pm / 17) * 256) * DM;
        const int rr0 = wr * 64 + fr, col0 = u.pn * BM + wc * 32 + 4 * fq;
#pragma unroll
        for (int ai = 0; ai < 2; ++ai)
#pragma unroll
            for (int m = 0; m < 4; ++m) { const size_t off = (size_t)(rr0 + ai * HALF + m * 16) * DM + col0;
#pragma unroll
                for (int bj = 0; bj < 2; ++bj)
#pragma unroll
                    for (int n = 0; n < 2; ++n) *(f32x4*)(dst + off + bj * HALF + n * 16) = acc[ai][bj][m][n]; }
    }
};
template <class Epi, class Sched, bool ALIGN_EPI = false, bool SP2 = false>
__device__ __forceinline__ void gemm_phase(PG8_LAS unsigned char* lds, const Gemm g, const Sched& S, const Epi& E, const int tid_in) {
    const int tid = tid_in  , wid = __builtin_amdgcn_readfirstlane(tid >> 6), lane = tid & 63, wr = wid >> 2, wc = wid & 3, fr = lane & 15, fq = lane >> 4;
    const int K = g.K, nt = K / BK;
    unsigned voffA[2], voffB[2];
#pragma unroll
    for (int i = 0; i < 2; ++i) { int R, C; stage_rc(tid * 16 + i * 8192, R, C); const int Rb = Epi::PERM ? ((R & ~31) + perm32(R & 31)) : R;
        voffA[i] = (unsigned)(R * g.lda + C) * 2u; voffB[i] = (unsigned)(Rb * g.ldb + C) * 2u; }
    const size_t kstep = (size_t)(BK * 2);
    const size_t hstepA = (size_t)HALF * g.lda * 2, hstepB = (size_t)HALF * g.ldb * 2;
    const size_t tstepA = 2 * hstepA, tstepB = 2 * hstepB;
    const unsigned ldsw = (unsigned)wid * 1024u;
    const int aoff = lds_byte(wr * 64 + fr, fq * 8), boff = lds_byte(wc * 32 + fr, fq * 8);
#define PG8_SA(b, h) (((b) * 2 + (h)) * HTB)
#define PG8_SB(b, h) ((4 + (b) * 2 + (h)) * HTB)
#define PG8_STAGE(bufoff, gbase, voff) do { _Pragma("unroll") for (int _i = 0; _i < 2; ++_i) \
        __builtin_amdgcn_global_load_lds((const unsigned*)((const char*)(gbase) + (voff)[_i]), (PG8_LAS unsigned*)(lds + (bufoff) + ldsw + _i * 8192), 16, 0, 0); } while (0)
#define PG8_LDA(dst, b, h) do { _Pragma("unroll") for (int m = 0; m < 4; ++m) _Pragma("unroll") for (int k = 0; k < 2; ++k) dst[m][k] = *(const PG8_LAS bf16x8*)(lds + PG8_SA(b, h) + aoff + m * 2048 + k * 1024); } while (0)
#define PG8_LDB(dst, b, h) do { _Pragma("unroll") for (int n = 0; n < 2; ++n) _Pragma("unroll") for (int k = 0; k < 2; ++k) dst[n][k] = *(const PG8_LAS bf16x8*)(lds + PG8_SB(b, h) + boff + n * 2048 + k * 1024); } while (0)
#define PG8_MMA(ai, bj, At, Bt) do { __builtin_amdgcn_s_setprio(1); _Pragma("unroll") for (int m = 0; m < 4; ++m) _Pragma("unroll") for (int n = 0; n < 2; ++n) _Pragma("unroll") for (int k = 0; k < 2; ++k) \
        acc[ai][bj][m][n] = __builtin_amdgcn_mfma_f32_16x16x32_bf16(Bt[n][k], At[m][k], acc[ai][bj][m][n], 0, 0, 0); __builtin_amdgcn_s_setprio(0); } while (0)
#define PG8_WAIT_V(n) asm volatile("s_waitcnt vmcnt(" #n ")" ::: "memory")
#define PG8_WAIT_L(n) asm volatile("s_waitcnt lgkmcnt(" #n ")" ::: "memory")
#define PG8_BAR __builtin_amdgcn_s_barrier()
#define PG8_SCHED __builtin_amdgcn_sched_barrier(0)
    Unit cur, nxt; int ui = 0;
    if (!S.next(0, cur)) return;
    f32x4 acc[2][2][4][2];
#pragma unroll
    for (int a = 0; a < 2; ++a)
#pragma unroll
        for (int b = 0; b < 2; ++b)
#pragma unroll
            for (int m = 0; m < 4; ++m)
#pragma unroll
                for (int n = 0; n < 2; ++n) acc[a][b][m][n] = (f32x4){0.f, 0.f, 0.f, 0.f};
    bf16x8 At[4][2], B0[2][2], B1[2][2];
    const char* cA = (const char*)g.A + (size_t)cur.pm * tstepA + (size_t)cur.ko * 2; const char* cB = (const char*)g.Bt + (size_t)cur.pn * tstepB + (size_t)cur.ko * 2;
    S.a_ready(cur);
    if constexpr (SP2) {
        PG8_STAGE(PG8_SB(0, 0), cB, voffB); PG8_STAGE(PG8_SB(0, 1), cB + hstepB, voffB); PG8_STAGE(PG8_SA(0, 0), cA, voffA); PG8_STAGE(PG8_SA(0, 1), cA + hstepA, voffA);
        if (wr == 1) PG8_BAR;
        PG8_WAIT_V(2); PG8_BAR;
        PG8_STAGE(PG8_SB(1, 0), cB + kstep, voffB); PG8_STAGE(PG8_SA(1, 0), cA + kstep, voffA); PG8_STAGE(PG8_SB(1, 1), cB + hstepB + kstep, voffB);
        PG8_WAIT_V(6); PG8_BAR;
    } else {
        PG8_STAGE(PG8_SB(0, 0), cB, voffB); PG8_STAGE(PG8_SA(0, 0), cA, voffA); PG8_STAGE(PG8_SB(0, 1), cB + hstepB, voffB); PG8_STAGE(PG8_SA(0, 1), cA + hstepA, voffA);
        if (wr == 1) PG8_BAR;
        PG8_WAIT_V(4); PG8_BAR;
        PG8_STAGE(PG8_SB(1, 0), cB + kstep, voffB); PG8_STAGE(PG8_SA(1, 0), cA + kstep, voffA); PG8_STAGE(PG8_SB(1, 1), cB + hstepB + kstep, voffB);
        PG8_WAIT_V(6); PG8_BAR;
    }
    for (;;) {
        const bool has_next = S.next(ui + 1, nxt);
        const char* nA = has_next ? (const char*)g.A + (size_t)nxt.pm * tstepA + (size_t)nxt.ko * 2 : cA; const char* nB = has_next ? (const char*)g.Bt + (size_t)nxt.pn * tstepB + (size_t)nxt.ko * 2 : cB;
        for (int t = 0; t < nt; t += 2) {
            const bool last = (t == nt - 2);
            const char* a1 = cA + (size_t)(t + 1) * kstep;
            const char* a2 = last ? nA : cA + (size_t)(t + 2) * kstep; const char* b2 = last ? nB : cB + (size_t)(t + 2) * kstep;
            const char* a3 = a2 + kstep; const char* b3 = b2 + kstep;
            if (last && has_next) S.a_ready(nxt);
            if constexpr (Epi::KHOOK) { if (t == 16 || t == 32) E.khook(acc, cur, t, wr, wc, fr, fq); }
            if constexpr (SP2) {
            PG8_LDB(B0, 0, 0); PG8_LDB(B1, 0, 1); PG8_SCHED; PG8_LDA(At, 0, 0); PG8_STAGE(PG8_SA(1, 1), a1 + hstepA, voffA);
            PG8_WAIT_V(8); PG8_WAIT_L(0); PG8_BAR; PG8_MMA(0, 0, At, B0); PG8_MMA(0, 1, At, B1); PG8_BAR; PG8_SCHED;
            PG8_LDA(At, 0, 1); PG8_STAGE(PG8_SB(0, 0), b2, voffB); PG8_STAGE(PG8_SB(0, 1), b2 + hstepB, voffB); PG8_STAGE(PG8_SA(0, 0), a2, voffA);
            PG8_WAIT_V(8); PG8_WAIT_L(0); PG8_BAR; PG8_MMA(1, 0, At, B0); PG8_MMA(1, 1, At, B1); PG8_BAR; PG8_SCHED;
            PG8_LDB(B0, 1, 0); PG8_LDB(B1, 1, 1); PG8_SCHED; PG8_LDA(At, 1, 0); PG8_STAGE(PG8_SA(0, 1), a2 + hstepA, voffA);
            PG8_WAIT_V(8); PG8_WAIT_L(0); PG8_BAR; PG8_MMA(0, 0, At, B0); PG8_MMA(0, 1, At, B1); PG8_BAR; PG8_SCHED;
            PG8_LDA(At, 1, 1); PG8_STAGE(PG8_SB(1, 0), b3, voffB); PG8_STAGE(PG8_SB(1, 1), b3 + hstepB, voffB); PG8_STAGE(PG8_SA(1, 0), a3, voffA);
            PG8_WAIT_V(8); PG8_WAIT_L(0); PG8_BAR; PG8_MMA(1, 0, At, B0); PG8_MMA(1, 1, At, B1); PG8_BAR; PG8_SCHED;
            } else {
            PG8_LDB(B0, 0, 0); PG8_SCHED; PG8_LDA(At, 0, 0); PG8_STAGE(PG8_SA(1, 1), a1 + hstepA, voffA);
            PG8_WAIT_L(8); PG8_BAR; PG8_WAIT_L(0); PG8_MMA(0, 0, At, B0); PG8_BAR; PG8_SCHED;
            PG8_LDB(B1, 0, 1); PG8_STAGE(PG8_SB(0, 0), b2, voffB);
            PG8_BAR; PG8_WAIT_L(0); PG8_MMA(0, 1, At, B1); PG8_BAR;
            PG8_LDA(At, 0, 1); PG8_STAGE(PG8_SA(0, 0), a2, voffA);
            PG8_BAR; PG8_WAIT_L(0); PG8_MMA(1, 0, At, B0); PG8_BAR; PG8_SCHED;
            PG8_STAGE(PG8_SB(0, 1), b2 + hstepB, voffB);
            PG8_WAIT_V(6); PG8_BAR; PG8_MMA(1, 1, At, B1); PG8_BAR;
            PG8_LDB(B0, 1, 0); PG8_SCHED; PG8_LDA(At, 1, 0); PG8_STAGE(PG8_SA(0, 1), a2 + hstepA, voffA);
            PG8_WAIT_L(8); PG8_BAR; PG8_WAIT_L(0); PG8_MMA(0, 0, At, B0); PG8_BAR; PG8_SCHED;
            PG8_LDB(B1, 1, 1); PG8_STAGE(PG8_SB(1, 0), b3, voffB);
            PG8_BAR; PG8_WAIT_L(0); PG8_MMA(0, 1, At, B1); PG8_BAR;
            PG8_LDA(At, 1, 1); PG8_STAGE(PG8_SA(1, 0), a3, voffA);
            PG8_BAR; PG8_WAIT_L(0); PG8_MMA(1, 0, At, B0); PG8_BAR; PG8_SCHED;
            PG8_STAGE(PG8_SB(1, 1), b3 + hstepB, voffB);
            PG8_WAIT_V(6); PG8_BAR; PG8_MMA(1, 1, At, B1); PG8_BAR;
            }
        }
        if constexpr (ALIGN_EPI) { if (wr == 0) PG8_BAR; }
        if constexpr (!Epi::AFTER_DRAIN) { E(acc, cur, wr, wc, fr, fq); S.done(cur); }
        if (!has_next) break;
#pragma unroll
        for (int a = 0; a < 2; ++a)
#pragma unroll
            for (int b = 0; b < 2; ++b)
#pragma unroll
                for (int m = 0; m < 4; ++m)
#pragma unroll
                    for (int n = 0; n < 2; ++n) acc[a][b][m][n] = (f32x4){0.f, 0.f, 0.f, 0.f};
        cur = nxt; cA = nA; cB = nB; ++ui;
        if constexpr (ALIGN_EPI) { if (wr == 1) PG8_BAR; }
    }
    PG8_WAIT_V(0);
    if constexpr (!ALIGN_EPI) { if (wr == 0) PG8_BAR; }
    PG8_BAR;
    if constexpr (Epi::AFTER_DRAIN) { E.fused(acc, cur, wr, wc, fr, fq, lds, wid, lane); S.done(cur); }
#undef PG8_SA
#undef PG8_SB
#undef PG8_STAGE
#undef PG8_LDA
#undef PG8_LDB
#undef PG8_MMA
#undef PG8_WAIT_V
#undef PG8_WAIT_L
#undef PG8_BAR
#undef PG8_SCHED
}
}
namespace att {
using bf16 = __hip_bfloat16;
constexpr int D = 128, NW = 8, QBLK = 32, KVBLK = 64;
constexpr float SCALE = 0.088388347648318440f;
constexpr float THR = 8.f;
constexpr int SDEPTH = 2;
constexpr int LDQ = 2048, LDK = 512, LDV = 512, LDO = 2048;
constexpr size_t SHM_V = KVBLK * D * 2, SHM_K = KVBLK * D * 2, SHM_ATTN = 2 * SHM_V + 2 * SHM_K + NW * 64 * 4;
using bf16x8 = __attribute__((ext_vector_type(8))) short;
using s16x4  = __attribute__((ext_vector_type(4))) short;
using f32x16 = __attribute__((ext_vector_type(16))) float;
using f32x8  = __attribute__((ext_vector_type(8))) float;
using u32x4  = __attribute__((ext_vector_type(4))) unsigned;
#define KSWZ(row, colB) ((row) * 256 + ((colB) ^ (((row) & 7) << 4)))
#define SBAR() __builtin_amdgcn_sched_barrier(0)
__device__ __forceinline__ int crow(int r, int hi) { return (r & 3) + 8 * (r >> 2) + 4 * hi; }
__device__ __forceinline__ unsigned cvtpk(float lo, float hi) {
  unsigned r; asm volatile("v_cvt_pk_bf16_f32 %0, %1, %2" : "=v"(r) : "v"(lo), "v"(hi)); return r;
}
template <typename TIn> struct Stage;
template <> struct Stage<bf16>  { using T = bf16x8;
  __device__ static __forceinline__ T ld8(const bf16* p) { return *reinterpret_cast<const bf16x8*>(p); }
  __device__ static __forceinline__ bf16x8 tobf(T x) { return x; } };
__device__ __forceinline__ void partialSM(f32x16& p0, f32x16& p1, float& m_reg, float& mn, float& alpha) {
  constexpr float C = SCALE * 1.4426950408889634f;
  float pmax = p0[0]; for (int r = 1; r < 16; ++r) pmax = fmaxf(pmax, p0[r]); for (int r = 0; r < 16; ++r) pmax = fmaxf(pmax, p1[r]);
  { auto rr = __builtin_amdgcn_permlane32_swap(__float_as_uint(pmax), __float_as_uint(pmax), false, false);
    pmax = fmaxf(__uint_as_float(rr[0]), __uint_as_float(rr[1])); }
  if (__builtin_expect(__all(pmax - m_reg <= THR / SCALE), 1)) { mn = m_reg; alpha = 1.f; }
  else { mn = fmaxf(m_reg, pmax); alpha = __builtin_amdgcn_exp2f((m_reg - mn) * C); m_reg = mn; }
  float mnC = -mn * C;
  for (int r = 0; r < 16; ++r) p0[r] = fmaf(p0[r], C, mnC); for (int r = 0; r < 16; ++r) p1[r] = fmaf(p1[r], C, mnC);
  for (int r = 0; r < 16; ++r) p0[r] = __builtin_amdgcn_exp2f(p0[r]);
}
__device__ __forceinline__ void finishSM(f32x16& p0, f32x16& p1, float alpha, float& l_reg, bf16x8& pa0, bf16x8& pa1, bf16x8& pa2, bf16x8& pa3) {
  for (int r = 0; r < 16; ++r) p1[r] = __builtin_amdgcn_exp2f(p1[r]);
  float ps = 0; for (int r = 0; r < 16; ++r) ps += p0[r]; for (int r = 0; r < 16; ++r) ps += p1[r];
  { auto rr = __builtin_amdgcn_permlane32_swap(__float_as_uint(ps), __float_as_uint(ps), false, false);
    ps = __uint_as_float(rr[0]) + __uint_as_float(rr[1]); }
  l_reg = l_reg * alpha + ps;
#define PK4(P, BASE, OUT) do { unsigned a0 = cvtpk(P[BASE + 0], P[BASE + 1]), a1 = cvtpk(P[BASE + 2], P[BASE + 3]);   \
    unsigned b0 = cvtpk(P[BASE + 4], P[BASE + 5]), b1 = cvtpk(P[BASE + 6], P[BASE + 7]);                              \
    auto r0 = __builtin_amdgcn_permlane32_swap(a0, b0, false, false); auto r1 = __builtin_amdgcn_permlane32_swap(a1, b1, false, false); \
    u32x4 w = {r0[0], r1[0], r0[1], r1[1]}; OUT = *reinterpret_cast<bf16x8*>(&w); } while (0)
  PK4(p0, 0, pa0); PK4(p0, 8, pa1); PK4(p1, 0, pa2); PK4(p1, 8, pa3);
#undef PK4
}
__device__ __forceinline__ void qkt(f32x16& p0, f32x16& p1, const bf16* Ks, const bf16x8* qr, int r32, int hi) {
  p0 = f32x16{}; p1 = f32x16{};
  for (int d0 = 0; d0 < 8; ++d0) { int cb = (d0 * 16 + hi * 8) * 2;
    bf16x8 b0 = *reinterpret_cast<const bf16x8*>((const char*)Ks + KSWZ(r32, cb));
    bf16x8 b1 = *reinterpret_cast<const bf16x8*>((const char*)Ks + KSWZ(32 + r32, cb));
    p0 = __builtin_amdgcn_mfma_f32_32x32x16_bf16(b0, qr[d0], p0, 0, 0, 0);
    p1 = __builtin_amdgcn_mfma_f32_32x32x16_bf16(b1, qr[d0], p1, 0, 0, 0); }
}
__device__ __forceinline__ int v_st(int k, int c) { const int kk = (k & ~0xC) | ((k & 4) << 1) | ((k & 8) >> 1); return ((kk >> 3) * 4 + (c >> 5)) * 512 + ((kk & 7) * 32 + (c & 31)) * 2; }
__device__ __forceinline__ int v_rd_base(int lane) { return ((lane & 3) << 3) | (((lane >> 2) & 3) << 6) | (((lane >> 4) & 1) << 5) | (((lane >> 5) & 1) << 8); }
constexpr int v_rd_off(int d0, int ks, int half) { return d0 * 512 + ks * 4096 + half * 2048; }
template <int OFF> __device__ __forceinline__ s16x4 tr_read(int vb) {
  s16x4 r; asm volatile("ds_read_b64_tr_b16 %0, %1 offset:%2" : "=&v"(r) : "v"(vb), "i"(OFF) : "memory"); return r;
}
template <int D0> __device__ __forceinline__ void pv_one(f32x16& od, int vb, bf16x8 pa0, bf16x8 pa1, bf16x8 pa2, bf16x8 pa3) {
  const s16x4 l0 = tr_read<v_rd_off(D0, 0, 0)>(vb), h0 = tr_read<v_rd_off(D0, 0, 1)>(vb), l1 = tr_read<v_rd_off(D0, 1, 0)>(vb), h1 = tr_read<v_rd_off(D0, 1, 1)>(vb);
  const s16x4 l2 = tr_read<v_rd_off(D0, 2, 0)>(vb), h2 = tr_read<v_rd_off(D0, 2, 1)>(vb), l3 = tr_read<v_rd_off(D0, 3, 0)>(vb), h3 = tr_read<v_rd_off(D0, 3, 1)>(vb);
  asm volatile("s_waitcnt lgkmcnt(0)" ::: "memory"); SBAR();
#define PK(L, H) (bf16x8){L[0], L[1], L[2], L[3], H[0], H[1], H[2], H[3]}
  od = __builtin_amdgcn_mfma_f32_32x32x16_bf16(pa0, PK(l0, h0), od, 0, 0, 0);
  od = __builtin_amdgcn_mfma_f32_32x32x16_bf16(pa1, PK(l1, h1), od, 0, 0, 0);
  od = __builtin_amdgcn_mfma_f32_32x32x16_bf16(pa2, PK(l2, h2), od, 0, 0, 0);
  od = __builtin_amdgcn_mfma_f32_32x32x16_bf16(pa3, PK(l3, h3), od, 0, 0, 0);
#undef PK
}
__device__ __forceinline__ void pv_d0(f32x16* o, int vb, bf16x8 pa0, bf16x8 pa1, bf16x8 pa2, bf16x8 pa3) {
  pv_one<0>(o[0], vb, pa0, pa1, pa2, pa3); pv_one<1>(o[1], vb, pa0, pa1, pa2, pa3); pv_one<2>(o[2], vb, pa0, pa1, pa2, pa3); pv_one<3>(o[3], vb, pa0, pa1, pa2, pa3);
}

template <typename TQ>
__device__ __forceinline__ void attn_dense_body(const TQ* __restrict__ Qb, const bf16* __restrict__ Kh, const bf16* __restrict__ Vh,
                                                unsigned short* __restrict__ Ob, int seq, char* lds, const int tid_in,
                                                const int ldq, const float* __restrict__ gq, const float* __restrict__ rope, const int tpos0  ) {
  using St = Stage<bf16>; using SQ = Stage<TQ>;
  const int tid = tid_in  , wid = tid >> 6, lane = tid & 63, r32 = lane & 31, hi = lane >> 5;
  bf16* V_lds = (bf16*)lds; bf16* K_lds = (bf16*)(lds + 2 * SHM_V);
  float* ws = (float*)(lds + 2 * SHM_V + 2 * SHM_K) + wid * 64; float* li_l = ws; float* al_l = ws + 32;
  float m_reg = -1e30f, l_reg = 0; f32x16 o[4] = {}; bf16x8 qr[8];
  const TQ* Qw = Qb + (long)(wid * QBLK + r32) * ldq + hi * 8;
#pragma unroll
  for (int d0 = 0; d0 < 8; ++d0) qr[d0] = SQ::tobf(SQ::ld8(Qw + d0 * 16));
  {
    float x[8][8]; float ss = 0.f;
#pragma unroll
    for (int d0 = 0; d0 < 8; ++d0)
#pragma unroll
      for (int j = 0; j < 8; ++j) { x[d0][j] = __builtin_bit_cast(float, (unsigned)(unsigned short)qr[d0][j] << 16); ss += x[d0][j] * x[d0][j]; }
    ss += __shfl_xor(ss, 32);
    const float rstd = 1.0f / sqrtf(ss * (1.0f / 128.0f) + 1e-6f);
#pragma unroll
    for (int d0 = 0; d0 < 8; ++d0) { const f32x8 g8 = *reinterpret_cast<const f32x8*>(gq + d0 * 16 + hi * 8);
#pragma unroll
      for (int j = 0; j < 8; ++j) x[d0][j] *= rstd * g8[j]; }
    if (tpos0 >= 0) { const int t = tpos0 + wid * QBLK + r32;
#pragma unroll
      for (int ax = 0; ax < 2; ++ax) { const int pos = ax ? (t & 63) : (t >> 6);
#pragma unroll
        for (int e = 0; e < 2; ++e) {
          const f32x8 c8 = *reinterpret_cast<const f32x8*>(rope + pos * 32 + 16 * e + 8 * hi), s8 = *reinterpret_cast<const f32x8*>(rope + 2048 + pos * 32 + 16 * e + 8 * hi);
#pragma unroll
          for (int j = 0; j < 8; ++j) { const float lo = x[4 * ax + e][j], hh = x[4 * ax + e + 2][j];
            x[4 * ax + e][j] = lo * c8[j] - hh * s8[j]; x[4 * ax + e + 2][j] = hh * c8[j] + lo * s8[j]; } } } }
#pragma unroll
    for (int d0 = 0; d0 < 8; ++d0) { u32x4 w = {cvtpk(x[d0][0], x[d0][1]), cvtpk(x[d0][2], x[d0][3]), cvtpk(x[d0][4], x[d0][5]), cvtpk(x[d0][6], x[d0][7])}; qr[d0] = *reinterpret_cast<bf16x8*>(&w); }
  }
  const int sr = tid >> 4, sc = (tid & 15) * 8, vst0 = v_st(sr, sc), vst1 = v_st(32 + sr, sc);
  const int vb0 = (int)(uintptr_t)V_lds + v_rd_base(lane);
  struct { typename St::T vs0, vs1, ks0, ks1; } sr_[SDEPTH];
#define SLOAD(i, k0) do { sr_[i].vs0 = St::ld8(&Vh[(long)((k0) + sr) * LDV + sc]); sr_[i].vs1 = St::ld8(&Vh[(long)((k0) + 32 + sr) * LDV + sc]); \
    sr_[i].ks0 = St::ld8(&Kh[(long)((k0) + sr) * LDK + sc]); sr_[i].ks1 = St::ld8(&Kh[(long)((k0) + 32 + sr) * LDK + sc]); } while (0)
#define SWRITE(b, i) do { *(bf16x8*)((char*)V_lds + (b) * SHM_V + vst0) = St::tobf(sr_[i].vs0);          \
    *(bf16x8*)((char*)V_lds + (b) * SHM_V + vst1) = St::tobf(sr_[i].vs1); int kc = sc * 2;               \
    *(bf16x8*)((char*)K_lds + (b) * SHM_K + KSWZ(sr, kc)) = St::tobf(sr_[i].ks0);                       \
    *(bf16x8*)((char*)K_lds + (b) * SHM_K + KSWZ(32 + sr, kc)) = St::tobf(sr_[i].ks1); } while (0)
#define SWAIT() do { if constexpr (SDEPTH == 2) asm volatile("s_waitcnt vmcnt(4)" ::: "memory"); else asm volatile("s_waitcnt vmcnt(0)" ::: "memory"); } while (0)
#define RESC(a) do { if (__any((a) < 1.f)) { if (hi == 0) al_l[r32] = (a); asm volatile("s_waitcnt lgkmcnt(0)" ::: "memory"); \
    for (int d = 0; d < 4; ++d) for (int r = 0; r < 16; ++r) o[d][r] *= al_l[crow(r, hi)]; } } while (0)
  f32x16 pA0, pA1, pB0, pB1; float mnA, mnB, alA, alB; bf16x8 pa0, pa1, pa2, pa3; const int NT = seq / KVBLK;
  constexpr int SE = 0, SO = SDEPTH - 1;
  SLOAD(SE, 0); asm volatile("s_waitcnt vmcnt(0)" ::: "memory"); SWRITE(0, SE); __syncthreads();
  qkt(pA0, pA1, K_lds, qr, r32, hi); partialSM(pA0, pA1, m_reg, mnA, alA);
  SLOAD(SO, KVBLK); if constexpr (SDEPTH == 2) { if (2 < NT) SLOAD(SE, 2 * KVBLK); }
  SWAIT(); SWRITE(1, SO); __syncthreads();
  for (int j = 1; j + 1 < NT; j += 2) {
    SBAR(); qkt(pB0, pB1, (bf16*)((char*)K_lds + SHM_K), qr, r32, hi);
    finishSM(pA0, pA1, alA, l_reg, pa0, pa1, pa2, pa3); SBAR();
    SLOAD(SO, (j + SDEPTH) * KVBLK); SBAR();
    pv_d0(o, vb0, pa0, pa1, pa2, pa3); partialSM(pB0, pB1, m_reg, mnB, alB);
    __syncthreads(); SWAIT(); SWRITE(0, SE);
    RESC(alB); __syncthreads();
    SBAR(); qkt(pA0, pA1, K_lds, qr, r32, hi);
    finishSM(pB0, pB1, alB, l_reg, pa0, pa1, pa2, pa3); SBAR();
    if (SDEPTH == 1 || j + 3 < NT) SLOAD(SE, (j + 1 + SDEPTH) * KVBLK); SBAR();
    pv_d0(o, vb0 + (int)SHM_V, pa0, pa1, pa2, pa3); partialSM(pA0, pA1, m_reg, mnA, alA);
    __syncthreads(); SWAIT(); SWRITE(1, SO);
    RESC(alA); __syncthreads();
  }
  SBAR(); qkt(pB0, pB1, (bf16*)((char*)K_lds + SHM_K), qr, r32, hi);
  finishSM(pA0, pA1, alA, l_reg, pa0, pa1, pa2, pa3); SBAR();
  pv_d0(o, vb0, pa0, pa1, pa2, pa3); partialSM(pB0, pB1, m_reg, mnB, alB);
  __syncthreads(); RESC(alB);
  finishSM(pB0, pB1, alB, l_reg, pa0, pa1, pa2, pa3); SBAR();
  pv_d0(o, vb0 + (int)SHM_V, pa0, pa1, pa2, pa3);
  if (hi == 0) li_l[r32] = l_reg; asm volatile("s_waitcnt lgkmcnt(0)" ::: "memory");
  float rli[16];
#pragma unroll
  for (int r = 0; r < 16; ++r) rli[r] = __builtin_amdgcn_rcpf(li_l[crow(r, hi)]);
  unsigned short* Ow = Ob + (long)(wid * QBLK) * LDO;
#pragma unroll
  for (int r = 0; r < 16; ++r) { int orow = crow(r, hi);
    for (int d0 = 0; d0 < 4; ++d0) Ow[(long)orow * LDO + d0 * 32 + r32] = (unsigned short)f2bf(o[d0][r] * rli[r]); }
  __syncthreads();
#undef SLOAD
#undef SWRITE
#undef SWAIT
#undef RESC
}
#undef KSWZ
#undef SBAR
}

#define XB_TMO      128
#define XB_XCNT(j)  (256  + 64 * (j))
#define XB_XSUB(j)  (1280 + 64 * (j))
#define XB_XGEN(j)  (2304 + 64 * (j))
#define XB_TOP      3328
#define XB_TOPGEN   3392
#define XCD_BAR_WORDS 3456
#define XB_SPIN_CAP (1u << 18)

__device__ __forceinline__ unsigned xb_ld(unsigned* p)              { return __hip_atomic_load(p, __ATOMIC_RELAXED, __HIP_MEMORY_SCOPE_AGENT); }
__device__ __forceinline__ unsigned xb_add(unsigned* p, unsigned v) { return __hip_atomic_fetch_add(p, v, __ATOMIC_RELAXED, __HIP_MEMORY_SCOPE_AGENT); }
__device__ __forceinline__ unsigned xb_xcc_id() { return (unsigned)__builtin_amdgcn_s_getreg((3 << 11) | 20) & 0xFu; }
#define XB_SPIN(cond, bar) do { unsigned _sp = 0; while (cond) { __builtin_amdgcn_s_sleep(1); \
    if ((++_sp & 255u) == 0u) { if (xb_ld(&(bar)[XB_TMO])) break; if (_sp > XB_SPIN_CAP) { atomicAdd(&(bar)[XB_TMO], 1u); break; } } } } while (0)

struct XcdBarrier {
    unsigned* bar; unsigned x;
    volatile LAS unsigned* st;
};

__device__ __forceinline__ XcdBarrier xcd_barrier_post(unsigned* bar, volatile LAS unsigned* st) {
    XcdBarrier b; b.bar = bar; b.x = xb_xcc_id(); b.st = st;
    if (threadIdx.x == 0) (void)xb_add(&bar[XB_XCNT(b.x)], 1u);
    return b;
}
__device__ __forceinline__ void xcd_barrier_complete(unsigned* bar, unsigned x, unsigned& nloc, unsigned& nx) {
    const unsigned G = gridDim.x * gridDim.y * gridDim.z;
    unsigned sum, cnt, mine, sp = 0u;
    for (;;) {
        sum = 0u; cnt = 0u; mine = 0u;
#pragma unroll
        for (unsigned j = 0; j < 16; ++j) { const unsigned c = xb_ld(&bar[XB_XCNT(j)]); sum += c; cnt += (c > 0u) ? 1u : 0u; mine = (j == x) ? c : mine; }
        if (sum == G) break;
        __builtin_amdgcn_s_sleep(1);
        if ((++sp & 255u) == 0u) { if (xb_ld(&bar[XB_TMO])) break; if (sp > XB_SPIN_CAP) { atomicAdd(&bar[XB_TMO], 1u); break; } }
    }
    nloc = mine > 0u ? mine : 1u; nx = cnt > 0u ? cnt : 1u;
}

__device__ __forceinline__ void xcd_barrier(const XcdBarrier& b) {
    asm volatile("s_waitcnt vmcnt(0)" ::: "memory");
    __syncthreads();
    if (threadIdx.x == 0) {
        unsigned* bar = b.bar;
        __builtin_amdgcn_s_waitcnt(0);
        unsigned nloc = b.st[0], nx = b.st[1];
        if (nloc == 0u) { xcd_barrier_complete(bar, b.x, nloc, nx); b.st[0] = nloc; b.st[1] = nx; }
        const unsigned old = xb_add(&bar[XB_XSUB(b.x)], 1u);
        const unsigned gen = old / nloc;
        if (old + 1u == (gen + 1u) * nloc) {
            __builtin_amdgcn_fence(__ATOMIC_RELEASE, "agent");
            asm volatile("s_waitcnt vmcnt(0)" ::: "memory");
            const unsigned og = xb_add(&bar[XB_TOP], 1u);
            const unsigned tg = og / nx;
            if (og + 1u == (tg + 1u) * nx) xb_add(&bar[XB_TOPGEN], 1u);
            else XB_SPIN(xb_ld(&bar[XB_TOPGEN]) == tg, bar);
            __builtin_amdgcn_fence(__ATOMIC_ACQUIRE, "agent");
            xb_add(&bar[XB_XGEN(b.x)], 1u);
            asm volatile("s_waitcnt vmcnt(0)" ::: "memory");
        } else {
            XB_SPIN(xb_ld(&bar[XB_XGEN(b.x)]) == gen, bar);
            __builtin_amdgcn_fence(__ATOMIC_ACQUIRE, "agent");
            asm volatile("s_waitcnt vmcnt(0)" ::: "memory");
        }
    }
    __syncthreads();
}
struct Ctx {
    LAS unsigned char* lds;
    volatile LAS unsigned* MISC;
    gu32* ctl;
    int tid, lane, wave, G, bid;
    float* out; unsigned char* ws;
};
__device__ __forceinline__ const float* inp(const Ctx& F, int i) { const unsigned long long v = *(volatile LAS unsigned long long*)(F.lds + INTAB_OFF + 8 * i);
    const unsigned lo = __builtin_amdgcn_readfirstlane((unsigned)v), hi = __builtin_amdgcn_readfirstlane((unsigned)(v >> 32)); return (const float*)(const GAS float*)(((unsigned long long)hi << 32) | lo); }
#define WSP(T, off) ((T*)(F.ws + (off)))
__device__ __forceinline__ void sincos_rev(float ang, float& s, float& c) {
    float t = ang * 0.15915494309189535f; t -= rintf(t); s = __builtin_amdgcn_sinf(t); c = __builtin_amdgcn_cosf(t); }

__device__ __forceinline__ void transpose_item(const float* W, int Nsrc, int nsrc0  , int k0, bf16* WT, int K, int ndst0, LAS float* scr, int lane, int kd = 0  ) {
    const int c = lane & 7;
    if (nsrc0 < 0) {
#pragma unroll
        for (int j = 0; j < 4; ++j) { const int n = (lane >> 3) + 8 * j; *(GAS v4u*)(WT + (size_t)(ndst0 + n) * K + kd + k0 + 8 * c) = (v4u){0u, 0u, 0u, 0u}; }
        return;
    }
    float wv[32];
#pragma unroll
    for (int i = 0; i < 32; ++i) wv[i] = __builtin_nontemporal_load((const GAS float*)(W + (size_t)(k0 + 2 * i + (lane >> 5)) * Nsrc + nsrc0 + (lane & 31)));
#pragma unroll
    for (int i = 0; i < 32; ++i) scr[(2 * i + (lane >> 5)) * 33 + (lane & 31)] = wv[i];
    LDS_WAIT(); asm volatile("" ::: "memory");
#pragma unroll
    for (int j = 0; j < 4; ++j) { const int n = (lane >> 3) + 8 * j; const LAS float* s = scr + (8 * c) * 33 + n;
        v4u o; o.x = pk2(s[0 * 33], s[1 * 33]); o.y = pk2(s[2 * 33], s[3 * 33]); o.z = pk2(s[4 * 33], s[5 * 33]); o.w = pk2(s[6 * 33], s[7 * 33]);
        *(GAS v4u*)(WT + (size_t)(ndst0 + n) * K + kd + k0 + 8 * c) = o; }
    LDS_WAIT(); asm volatile("" ::: "memory");
}
constexpr int TI_IN = 64 * (NP / 32), TI_GLU = 16 * 32, TI_PS = 16 * 128, TI_PA = 32 * 128, TI_O = 64 * 128;
constexpr int TI_PER_L = TI_IN + TI_GLU + 2 * TI_PS + TI_PA + TI_O;
constexpr int TJ_ITEMS = 32, TJ_JOBS = TI_PER_L / TJ_ITEMS;
__device__ __forceinline__ void transpose_one(Ctx& F, int l, int r, LAS float* scr) {
    if (r < TI_IN) { const int nblk = NP / 32, kb = r / nblk, nb = r % nblk, nd = nb * 32;
        const int ns = nd < 5120 ? nd : (nd < 22528 ? nd + 32 : (nd < 22560 ? nd - 22528 + 5120 : -1));
        transpose_item(inp(F, I_WIN) + (size_t)l * DM * NIN, NIN, ns, kb * 64, WSP(bf16, WS_WIN) + (size_t)l * NP * DM, DM, nd, scr, F.lane); return; }
    r -= TI_IN;
    if (r < TI_GLU) { const int kb = r / 32, nb = r % 32; transpose_item(inp(F, I_WGLU) + (size_t)l * 1024 * 1024, 1024, nb * 32, kb * 64, WSP(bf16, WS_WGLU) + (size_t)l * 1024 * 1024, 1024, nb * 32, scr, F.lane); return; }
    r -= TI_GLU;
    if (r < TI_PS) { const int kb = r / 128, nb = r % 128; transpose_item(inp(F, I_WPS) + (size_t)l * 1024 * DM, DM, nb * 32, kb * 64, WSP(bf16, WS_WCAT) + (size_t)l * DM * DM, DM, nb * 32, scr, F.lane, 0); return; }
    r -= TI_PS;
    if (r < TI_PS) { const int kb = r / 128, nb = r % 128; transpose_item(inp(F, I_WPG) + (size_t)l * 1024 * DM, DM, nb * 32, kb * 64, WSP(bf16, WS_WCAT) + (size_t)l * DM * DM, DM, nb * 32, scr, F.lane, 1024); return; }
    r -= TI_PS;
    if (r < TI_PA) { const int kb = r / 128, nb = r % 128; transpose_item(inp(F, I_WPA) + (size_t)l * 2048 * DM, DM, nb * 32, kb * 64, WSP(bf16, WS_WCAT) + (size_t)l * DM * DM, DM, nb * 32, scr, F.lane, 2048); return; }
    r -= TI_PA;
    { const int kb = r / 128, nb = r % 128; transpose_item(inp(F, I_WOUT) + (size_t)l * DM * DM, DM, nb * 32, kb * 64, WSP(bf16, WS_WO) + (size_t)l * DM * DM, DM, nb * 32, scr, F.lane); }
}
__device__ __forceinline__ void ph_transposes(Ctx& F) {
    LAS float* scr = (LAS float*)(F.lds + RING_OFF + F.wave * 16384);
    const int gw = F.bid * NWAVES + F.wave, NGW = F.G * NWAVES;
    for (int r = gw; r < TI_PER_L; r += NGW) transpose_one(F, 0, r, scr);
}
__device__ __forceinline__ void transpose_job(Ctx& F, int layer, int j) {
    LAS float* scr = (LAS float*)(F.lds + RING_OFF + F.wave * 16384);
#pragma unroll 1
    for (int i = 0; i < TJ_ITEMS / NWAVES; ++i) transpose_one(F, layer, j * TJ_ITEMS + i * NWAVES + F.wave, scr);
}
__device__ __forceinline__ void transposes_fill(Ctx& F, unsigned* cnt, int jlo, int jhi) {
    LAS float* scr = (LAS float*)(F.lds + RING_OFF + F.wave * 16384);
    for (;;) {
        __syncthreads();
        if (F.tid == 0) F.MISC[17] = __hip_atomic_fetch_add(cnt, 1u, RLX_AGENT);
        __syncthreads();
        const int j = jlo + (int)F.MISC[17];
        if (j >= jhi) break;
#pragma unroll 1
        for (int i = 0; i < TJ_ITEMS / NWAVES; ++i) transpose_one(F, 1, j * TJ_ITEMS + i * NWAVES + F.wave, scr);
    }
}
__device__ __forceinline__ void mod_partial_item(Ctx& F, int item) {
    LAS float* sc = (LAS float*)(F.lds + RING_OFF);
    {
        const int l = item / 192, rem = item % 192, nblk = rem / 32, ks = rem % 32;
        __syncthreads();
        if (F.tid < 384) { const int rr = F.tid / 128, kk = F.tid % 128; const float v = rr < 2 ? inp(F, I_C)[rr * DM + ks * 128 + kk] : inp(F, I_CCTX)[ks * 128 + kk]; sc[F.tid] = siluf_(v); }
        __syncthreads();
        const int n = nblk * 2048 + F.tid * 4;
        const float* w = inp(F, I_WMOD) + ((size_t)l * DM + (size_t)ks * 128) * 12288 + n;
        f32x4 a0 = {0.f, 0.f, 0.f, 0.f}, a1 = a0, a2 = a0;
#pragma unroll 8
        for (int kk = 0; kk < 128; ++kk) { const f32x4 wv = __builtin_nontemporal_load((const GAS f32x4*)(w + (size_t)kk * 12288)); a0 += sc[kk] * wv; a1 += sc[128 + kk] * wv; a2 += sc[256 + kk] * wv; }
        float* o = WSP(float, WS_MODP) + ((size_t)(l * 32 + ks) * 3) * 12288 + n;
        *(f32x4*)o = a0; *(f32x4*)(o + 12288) = a1; *(f32x4*)(o + 2 * 12288) = a2;
    }
    __syncthreads();
}
__device__ __forceinline__ void ph_mod_reduce(Ctx& F) {
    const float* mp = WSP(float, WS_MODP); float* mo = WSP(float, WS_MOD);
    for (int e = F.bid * NTHR + F.tid; e < 2 * 3 * 12288; e += F.G * NTHR) {
        const int l = e / 36864, rem = e % 36864, r = rem / 12288, n = rem % 12288;
        float s = inp(F, I_BMOD)[l * 12288 + n];
        for (int ks = 0; ks < 32; ++ks) s += mp[((size_t)(l * 32 + ks) * 3 + r) * 12288 + n];
        mo[e] = s;
    }
}
__device__ __forceinline__ void ph_rope_table(Ctx& F) {
    float* tb = WSP(float, WS_ROPE);
    for (int e = F.bid * NTHR + F.tid; e < 2048; e += F.G * NTHR) {
        const int pos = e >> 5, f = e & 31;
        const float inv = exp2f(-(float)f * (13.287712379549449f / 32.0f));
        float s, c; sincos_rev((float)pos * inv, s, c);
        tb[e] = c; tb[2048 + e] = s;
    }
}
__device__ __forceinline__ void s5_mats_item(Ctx& F, int item) {
    LAS float* L = (LAS float*)(F.lds + RING_OFF);
    LAS float* zr = L; LAS float* zi = L + 64; LAS float* qr = L + 128; LAS float* qi = L + 192;
    LAS float* bbr = L + 256; LAS float* bbi = bbr + 1024;
    LAS float* cmr = bbi + 1024; LAS float* cmi = cmr + 1024;
    LAS float* pdr = cmi + 1024; LAS float* pdi = pdr + 1024;
    {
        const int ld = item >> 6, g = item & 63;
        bf16* TG = WSP(bf16, WS_TG) + (size_t)item * 256 * 384;
        bf16* WT = WSP(bf16, WS_WT) + (size_t)item * 128 * 256;
        float* L16 = WSP(float, WS_L16) + (size_t)item * 128;
        __syncthreads();
        if (F.tid < 64) { const int n = F.tid; const size_t pi = ((size_t)ld * 64 + g) * 64 + n;
            const float lr = fminf(inp(F, I_LAMRE)[pi], -1e-4f), li = inp(F, I_LAMIM)[pi], dt = __expf(inp(F, I_LOGDT)[ld * 64 + g]);
            const float a = lr * dt, b = li * dt; zr[n] = a; zi[n] = b;
            float sb, cb, sh, ch; sincos_rev(b, sb, cb); sincos_rev(0.5f * b, sh, ch);
            const float em1 = expm1f(a), ea = em1 + 1.0f;
            const float nr = em1 * cb - 2.0f * sh * sh, ni = ea * sb;
            const float den = 1.0f / (lr * lr + li * li);
            qr[n] = (nr * lr + ni * li) * den; qi[n] = (ni * lr - nr * li) * den;
            float s16, c16; sincos_rev(16.0f * b, s16, c16); const float m16 = __expf(16.0f * a);
            L16[2 * n] = m16 * c16; L16[2 * n + 1] = m16 * s16; }
        __syncthreads();
        for (int e = F.tid; e < 1024; e += NTHR) {
            { const int n = e >> 4; const size_t bi = (((size_t)ld * 64 + g) * 64) * 16 + e; const float br = inp(F, I_BRE)[bi], bim = inp(F, I_BIM)[bi];
              bbr[e] = qr[n] * br - qi[n] * bim; bbi[e] = qr[n] * bim + qi[n] * br; }
            { const size_t ci = (((size_t)ld * 64 + g) * 16) * 64 + e; cmr[e] = inp(F, I_CRE)[ci]; cmi[e] = inp(F, I_CIM)[ci]; }
        }
        __syncthreads();
        for (int d = 0; d <= 16; ++d) {
            for (int e = F.tid; e < 1024; e += NTHR) {
                { const int n = e & 63; float s, c; sincos_rev((float)d * zi[n], s, c); const float mg = __expf((float)d * zr[n]); const float er = mg * c, ei = mg * s;
                  pdr[e] = cmr[e] * er - cmi[e] * ei; pdi[e] = cmr[e] * ei + cmi[e] * er; }
                if (d <= 15) { const int n = e >> 4, p = e & 15; float s, c; sincos_rev((float)d * zi[n], s, c); const float mg = __expf((float)d * zr[n]); const float er = mg * c, ei = mg * s;
                  const float vr = er * bbr[e] - ei * bbi[e], vi = er * bbi[e] + ei * bbr[e];
                  WT[(size_t)(2 * n) * 256 + (15 - d) * 16 + p] = (bf16)f2bf(vr); WT[(size_t)(2 * n + 1) * 256 + (15 - d) * 16 + p] = (bf16)f2bf(vi); }
            }
            __syncthreads();
            if (d <= 15 && F.tid < 256) { const int pp = F.tid >> 4, p = F.tid & 15; float s = 0.f;
                for (int n = 0; n < 64; ++n) s += pdr[pp * 64 + n] * bbr[n * 16 + p] - pdi[pp * 64 + n] * bbi[n * 16 + p];
                const bf16 v = (bf16)f2bf(s);
                for (int i = d; i < 16; ++i) TG[(size_t)(i * 16 + pp) * 384 + (i - d) * 16 + p] = v; }
            if (d >= 1) for (int e = F.tid; e < 1024; e += NTHR) { const int pp = e >> 6, n = e & 63;
                TG[(size_t)((d - 1) * 16 + pp) * 384 + 256 + 2 * n] = (bf16)f2bf(pdr[e]); TG[(size_t)((d - 1) * 16 + pp) * 384 + 256 + 2 * n + 1] = (bf16)f2bf(-pdi[e]); }
            __syncthreads();
        }
        for (int e = F.tid; e < 256 * 256; e += NTHR) { const int row = e >> 8, col = e & 255; if ((col >> 4) > (row >> 4)) TG[(size_t)row * 384 + col] = 0; }
    }
    __syncthreads();
}
__device__ __forceinline__ void ph_norm(Ctx& F, int layer, bool ctxsplit) {
    const int gw = F.bid * NWAVES + F.wave, NGW = F.G * NWAVES;
    const float* ng = inp(F, I_NORMG) + layer * DM; const float* MODl = WSP(float, WS_MOD) + (size_t)layer * 3 * 12288;
    for (int r = gw; r < MROWS; r += NGW) {
        const int b = r / RPB, j = r % RPB; const bool isctx = j < TC;
        const bool fold = (layer == 1 && isctx && ctxsplit);
        const float* src = (layer == 0 || fold) ? (isctx ? inp(F, I_CTX) + ((size_t)b * TC + j) * DM : inp(F, I_X) + ((size_t)b * TL + (j - TC)) * DM) : WSP(float, WS_X1) + (size_t)r * DM;
        const float* md = MODl + (size_t)(isctx ? 2 : b) * 12288;
        const GAS f32x4* xr = (const GAS f32x4*)src + F.lane;
        f32x4 v[16]; float s = 0.f;
#pragma unroll
        for (int q = 0; q < 16; ++q) v[q] = layer == 0 ? __builtin_nontemporal_load(xr + 64 * q) : xr[64 * q];
        if (fold) { const float* g0v = WSP(float, WS_MOD) + (size_t)2 * 12288 + 8192 + 4 * F.lane; const float* pt = WSP(float, WS_PART) + ((size_t)b * 256 + j) * DM + 4 * F.lane;
#pragma unroll 1
            for (int ks = 0; ks < 8; ++ks) {
#pragma unroll
                for (int q = 0; q < 16; ++q) v[q] += *(const GAS f32x4*)(g0v + 256 * q) * *(const GAS f32x4*)(pt + 256 * q);
                pt += (size_t)512 * DM; } }
#pragma unroll
        for (int q = 0; q < 16; ++q) s += (v[q].x * v[q].x + v[q].y * v[q].y) + (v[q].z * v[q].z + v[q].w * v[q].w);
        const float rstd = 1.0f / sqrtf(wave_sum(s) * (1.0f / DM) + EPS);
        GAS v2u* o8 = (GAS v2u*)(WSP(bf16, WS_H) + (size_t)r * DM) + F.lane;
#pragma unroll
        for (int q = 0; q < 16; ++q) { const int d0 = 256 * q + 4 * F.lane;
            const f32x4 g4 = *(const GAS f32x4*)(ng + d0), sh = *(const GAS f32x4*)(md + d0), sc = *(const GAS f32x4*)(md + 4096 + d0);
            const f32x4 y = v[q] * rstd * g4 * (sc + 1.0f) + sh;
            o8[64 * q] = (v2u){pk2(y.x, y.y), pk2(y.z, y.w)}; }
    }
}
__device__ __forceinline__ void ph_final(Ctx& F) {
    const int gw = F.bid * NWAVES + F.wave, NGW = F.G * NWAVES; const float* fg = inp(F, I_FINALG);
    for (int r = gw; r < NB * TL; r += NGW) {
        GAS f32x4* xr = (GAS f32x4*)(F.out + (size_t)r * DM) + F.lane;
        f32x4 v[16]; float s = 0.f;
#pragma unroll
        for (int q = 0; q < 16; ++q) { v[q] = __builtin_nontemporal_load(xr + 64 * q); s += (v[q].x * v[q].x + v[q].y * v[q].y) + (v[q].z * v[q].z + v[q].w * v[q].w); }
        const float rstd = 1.0f / sqrtf(wave_sum(s) * (1.0f / DM) + EPS);
#pragma unroll
        for (int q = 0; q < 16; ++q) { const f32x4 g4 = *(const GAS f32x4*)(fg + 256 * q + 4 * F.lane); __builtin_nontemporal_store(v[q] * rstd * g4, xr + 64 * q); }
    }
}
__device__ __forceinline__ void attn_prep_rows(Ctx& F, int layer, int r_lo, int r_hi) {
    const bf16* P = WSP(bf16, WS_P); const float* tb = WSP(float, WS_ROPE);
    const float* gq = inp(F, I_AQG) + layer * 128; const float* gk = inp(F, I_AKG) + layer * 128;
    const int lane = F.lane, hq = lane >> 4, li = lane & 15, d0 = 8 * li;
    const f32x4 gqa = *(const GAS f32x4*)(gq + d0), gqb = *(const GAS f32x4*)(gq + d0 + 4), gka = *(const GAS f32x4*)(gk + d0), gkb = *(const GAS f32x4*)(gk + d0 + 4);
    const float sg = (li & 4) ? 1.0f : -1.0f; const int f0 = 8 * (li & 3);
    for (int it = r_lo * 2 + F.wave; it < r_hi * 2; it += NWAVES) {
        const int r = it >> 1, grp = 4 + (it & 1); const int j = r % RPB; const bool isctx = j < TC;
        const int scol = grp < 4 ? C_AQ + grp * 512 : (grp == 4 ? C_AK : C_AV);
        const v4u w = *(const GAS v4u*)(P + (size_t)r * NP + scol + hq * 128 + d0);
        if (grp == 5) { *(GAS v4u*)(WSP(bf16, WS_VN) + (size_t)r * 512 + hq * 128 + d0) = w; continue; }
        f32x4 xa = (f32x4){bflo(w.x), bfhi(w.x), bflo(w.y), bfhi(w.y)}, xb = (f32x4){bflo(w.z), bfhi(w.z), bflo(w.w), bfhi(w.w)};
        float ss = (xa.x * xa.x + xa.y * xa.y) + (xa.z * xa.z + xa.w * xa.w) + (xb.x * xb.x + xb.y * xb.y) + (xb.z * xb.z + xb.w * xb.w);
        ss += __shfl_xor(ss, 1); ss += __shfl_xor(ss, 2); ss += __shfl_xor(ss, 4); ss += __shfl_xor(ss, 8);
        const float rstd = 1.0f / sqrtf(ss * (1.0f / 128.0f) + EPS);
        xa = xa * rstd * (grp < 4 ? gqa : gka); xb = xb * rstd * (grp < 4 ? gqb : gkb);
        if (!isctx) {
            const int t = j - TC; const int pos = (li >> 3) ? (t & 63) : (t >> 6);
            const f32x4 ca = *(const GAS f32x4*)(tb + pos * 32 + f0), cb = *(const GAS f32x4*)(tb + pos * 32 + f0 + 4), sa = *(const GAS f32x4*)(tb + 2048 + pos * 32 + f0), sb = *(const GAS f32x4*)(tb + 2048 + pos * 32 + f0 + 4);
            f32x4 pa, pb;
#pragma unroll
            for (int e = 0; e < 4; ++e) { pa[e] = __shfl_xor(xa[e], 4); pb[e] = __shfl_xor(xb[e], 4); }
            xa = xa * ca + sg * pa * sa; xb = xb * cb + sg * pb * sb;
        }
        const v4u o = (v4u){pk2(xa.x, xa.y), pk2(xa.z, xa.w), pk2(xb.x, xb.y), pk2(xb.z, xb.w)};
        bf16* dst = grp < 4 ? WSP(bf16, WS_QN) + (size_t)r * 2048 + (grp * 4 + hq) * 128 + d0 : WSP(bf16, WS_KN) + (size_t)r * 512 + hq * 128 + d0;
        *(GAS v4u*)dst = o;
    }
}
__device__ __forceinline__ float log_sigmoid_(float z) { return fminf(z, 0.f) - __logf(1.0f + __expf(-fabsf(z))); }
__device__ __forceinline__ void gla_prep_item(Ctx& F, int layer, int it) {
    const bf16* P = WSP(bf16, WS_P);
    LAS float* lrs = (LAS float*)(F.lds + RING_OFF);
    LAS unsigned char* tq = F.lds + RING_OFF + 4096 + F.wave * 17408;
    LAS unsigned char* tk = tq + 4608;
    LAS float* bbs = (LAS float*)(tq + 9216) + F.lane;
    const int lane = F.lane, h = F.wave, col = h * 64 + lane, fr = lane & 15, fq = lane >> 4;
    {
        const int b = it / GNCH, c = it % GNCH; const size_t r0 = (size_t)b * RPB + (size_t)c * GCH;
        __syncthreads();
        { const int tok = F.tid >> 4, cc = (F.tid & 15) * 2; const unsigned w = *(const GAS unsigned*)(P + (r0 + tok) * NP + C_LR + cc); lrs[tok * 32 + cc] = bflo(w); lrs[tok * 32 + cc + 1] = bfhi(w); }
        __syncthreads();
        bf16 qraw[32], kraw[32];
        { const bf16* pq = P + r0 * NP + C_GQ + col;
#pragma unroll
          for (int t = 0; t < 32; ++t) { qraw[t] = pq[(size_t)t * NP]; kraw[t] = pq[(size_t)t * NP + (C_GK - C_GQ)]; } }
#pragma unroll 1
        for (int dir = 0; dir < 2; ++dir) {
            float wa[16];
#pragma unroll
            for (int r = 0; r < 16; ++r) wa[r] = inp(F, I_GWA)[((size_t)(layer * 2 + dir) * 16 + r) * 512 + col];
            const float ba = inp(F, I_GBA)[(layer * 2 + dir) * 512 + col];
#pragma unroll 2
            for (int t = 0; t < 32; ++t) { float z = ba;
#pragma unroll
                for (int r = 0; r < 16; ++r) z += lrs[t * 32 + dir * 16 + r] * wa[r];
                bbs[64 * t] = log_sigmoid_(z) * (1.0f / 16.0f); }
            float run = 0.f;
            if (dir == 0) {
#pragma unroll 4
                for (int t = 0; t < 32; ++t) { run += bbs[64 * t]; bbs[64 * t] = run; }
            } else {
#pragma unroll 4
                for (int t = 31; t >= 0; --t) { run += bbs[64 * t]; bbs[64 * t] = run; }
            }
            const float bend = run;
            bf16* QH = WSP(bf16, WS_QH) + (size_t)dir * MROWS * 512;
            bf16* KHT = WSP(bf16, WS_KHT) + ((((size_t)dir * 272 + it) * 8 + h) * 64 + lane) * 32;
#pragma unroll
            for (int tg = 0; tg < 4; ++tg) { unsigned kw[4];
#pragma unroll
                for (int i2 = 0; i2 < 4; ++i2) { float khv[2];
#pragma unroll
                    for (int e = 0; e < 2; ++e) { const int t = 8 * tg + 2 * i2 + e; const float bt = bbs[64 * t];
                        const float q = bf2f(qraw[t]) * 0.125f, k = bf2f(kraw[t]);
                        const float qh = q * __expf(bt), kt = k * __expf(-bt); khv[e] = k * __expf(bend - bt);
                        const bf16 qb = (bf16)f2bf(qh);
                        QH[(r0 + t) * 512 + col] = qb;
                        *(LAS bf16*)(tq + t * 144 + lane * 2) = qb; *(LAS bf16*)(tk + t * 144 + lane * 2) = (bf16)f2bf(kt); }
                    kw[i2] = pk2(khv[0], khv[1]); }
                *(GAS v4u*)(KHT + 8 * tg) = (v4u){kw[0], kw[1], kw[2], kw[3]}; }
            WSP(float, WS_DEC)[((size_t)dir * 272 + it) * 512 + col] = __expf(bend);
            LDS_WAIT(); asm volatile("" ::: "memory");
            bf16x8 af[2][2], bfr[2][2];
#pragma unroll
            for (int mb = 0; mb < 2; ++mb)
#pragma unroll
                for (int s = 0; s < 2; ++s) { af[mb][s] = *(const LAS bf16x8*)(tk + (16 * mb + fr) * 144 + 64 * s + 16 * fq); bfr[mb][s] = *(const LAS bf16x8*)(tq + (16 * mb + fr) * 144 + 64 * s + 16 * fq); }
            LDS_WAIT(); asm volatile("" ::: "memory");
            bf16* AM = WSP(bf16, WS_AM) + (((size_t)dir * 272 + it) * 8 + h) * 1024;
#pragma unroll
            for (int mb = 0; mb < 2; ++mb)
#pragma unroll
                for (int nb = 0; nb < 2; ++nb) { f32x4 dacc = {0.f, 0.f, 0.f, 0.f};
                    dacc = __builtin_amdgcn_mfma_f32_16x16x32_bf16(af[mb][0], bfr[nb][0], dacc, 0, 0, 0);
                    dacc = __builtin_amdgcn_mfma_f32_16x16x32_bf16(af[mb][1], bfr[nb][1], dacc, 0, 0, 0);
                    const int i = 16 * nb + fr, j0 = 16 * mb + 4 * fq; float vv[4];
#pragma unroll
                    for (int r = 0; r < 4; ++r) { const int j = j0 + r; const bool keep = dir == 0 ? (j <= i) : (j >= i); vv[r] = keep ? dacc[r] : 0.f; }
                    *(GAS v2u*)(AM + i * 32 + j0) = (v2u){pk2(vv[0], vv[1]), pk2(vv[2], vv[3])}; }
        }
#pragma unroll 1
        for (int half = 0; half < 2; ++half) { const int v = lane + 64 * half; bf16* VT = WSP(bf16, WS_VT) + (((size_t)it * 8 + h) * 128 + v) * 32;
            const bf16* pv = P + r0 * NP + C_GV + h * 128 + v;
            bf16 vr[32];
#pragma unroll
            for (int t = 0; t < 32; ++t) vr[t] = pv[(size_t)t * NP];
#pragma unroll
            for (int tg = 0; tg < 4; ++tg) *(GAS v4u*)(VT + 8 * tg) = (v4u){(unsigned)vr[8 * tg] | ((unsigned)vr[8 * tg + 1] << 16), (unsigned)vr[8 * tg + 2] | ((unsigned)vr[8 * tg + 3] << 16),
                                                                            (unsigned)vr[8 * tg + 4] | ((unsigned)vr[8 * tg + 5] << 16), (unsigned)vr[8 * tg + 6] | ((unsigned)vr[8 * tg + 7] << 16)}; }
    }
    __syncthreads();
}
constexpr int GLA_SLOT = 18688, GLA_R = 7, GLA_D = 6, GLA_JUNK = GLA_R * GLA_SLOT;
__device__ __forceinline__ int gla_chunk_of(int dir, int ci) { return dir == 0 ? ci : (ci < GNCTX ? GNCTX - 1 - ci : GNCH - 1 + GNCTX - ci); }
__device__ __forceinline__ void gla_issue(Ctx& F, int dir, int b, int h, int c, int slot) {
    const int lane = F.lane, w = F.wave; const int it = b * GNCH + c; const size_t di = (size_t)dir * 272 + it;
    LAS unsigned char* sl = F.lds + RING_OFF + slot * GLA_SLOT;
    const unsigned char* vt = (const unsigned char*)(WSP(bf16, WS_VT) + ((size_t)it * 8 + h) * 4096);
    __builtin_amdgcn_global_load_lds((const GAS unsigned*)(vt + 1024 * w + 16 * lane), (LAS unsigned*)(sl + 1024 * w), 16, 0, 0);
    if (w < 4) { const unsigned char* kh = (const unsigned char*)(WSP(bf16, WS_KHT) + (di * 8 + h) * 2048);
        __builtin_amdgcn_global_load_lds((const GAS unsigned*)(kh + 1024 * w + 16 * lane), (LAS unsigned*)(sl + 8192 + 1024 * w), 16, 0, 0); }
    else { const unsigned char* qh = (const unsigned char*)(WSP(bf16, WS_QH) + ((size_t)dir * MROWS + (size_t)b * RPB + (size_t)c * GCH + 8 * (w - 4) + (lane >> 3)) * 512 + h * 64);
        __builtin_amdgcn_global_load_lds((const GAS unsigned*)(qh + 16 * (lane & 7)), (LAS unsigned*)(sl + 12288 + 1024 * (w - 4)), 16, 0, 0); }
    if (w < 2) { const unsigned char* am = (const unsigned char*)(WSP(bf16, WS_AM) + (di * 8 + h) * 1024);
        __builtin_amdgcn_global_load_lds((const GAS unsigned*)(am + 1024 * w + 16 * lane), (LAS unsigned*)(sl + 16384 + 1024 * w), 16, 0, 0); }
    else if (w == 2) { const unsigned char* dc = (const unsigned char*)(WSP(float, WS_DEC) + di * 512 + h * 64);
        if (lane < 16) __builtin_amdgcn_global_load_lds((const GAS unsigned*)(dc + 16 * lane), (LAS unsigned*)(sl + 18432), 16, 0, 0); }
    else __builtin_amdgcn_global_load_lds((const GAS unsigned*)(vt + 16 * lane), (LAS unsigned*)(F.lds + RING_OFF + GLA_JUNK), 16, 0, 0);
}
__device__ __forceinline__ void gla_seq_job(Ctx& F, int layer, int job) {
    const int dir = job >> 4, b = (job >> 3) & 1, h = job & 7; const int lane = F.lane, fr = lane & 15, fq = lane >> 4, w = F.wave;
    f32x4 S[4];
#pragma unroll
    for (int m = 0; m < 4; ++m) S[m] = (f32x4){0.f, 0.f, 0.f, 0.f};
    float* GO = WSP(float, WS_GO) + (size_t)dir * MROWS * 1024;
    asm volatile("s_waitcnt vmcnt(0)" ::: "memory"); __builtin_amdgcn_s_barrier();
#pragma unroll 1
    for (int c0 = 0; c0 < GLA_D - 1; ++c0) gla_issue(F, dir, b, h, gla_chunk_of(dir, c0), c0);
    asm volatile("s_waitcnt vmcnt(0)" ::: "memory");
#pragma unroll 1
    for (int ci = 0; ci < GNCH; ++ci) {
        const int c = gla_chunk_of(dir, ci);
        { const int cn = ci + GLA_D - 1; gla_issue(F, dir, b, h, gla_chunk_of(dir, cn < GNCH ? cn : GNCH - 1), cn % GLA_R); }
        asm volatile("s_waitcnt vmcnt(55)" ::: "memory");
        __builtin_amdgcn_s_barrier(); asm volatile("" ::: "memory");
        const LAS unsigned char* sl = F.lds + RING_OFF + (ci % GLA_R) * GLA_SLOT;
        const bf16x8 vt = *(const LAS bf16x8*)(sl + (16 * w + fr) * 64 + 16 * fq);
        bf16x4 qa[2][2], qb[2][2]; bf16x8 am[2], kh[4]; f32x4 dec[4];
#pragma unroll
        for (int ib = 0; ib < 2; ++ib) {
#pragma unroll
            for (int s = 0; s < 2; ++s) { const LAS unsigned char* qp = sl + 12288 + (16 * ib + fr) * 128 + (32 * s + 4 * fq) * 2; qa[ib][s] = *(const LAS bf16x4*)qp; qb[ib][s] = *(const LAS bf16x4*)(qp + 32); }
            am[ib] = *(const LAS bf16x8*)(sl + 16384 + (16 * ib + fr) * 64 + 16 * fq); }
#pragma unroll
        for (int m = 0; m < 4; ++m) { dec[m] = *(const LAS f32x4*)(sl + 18432 + (16 * m + 4 * fq) * 4); kh[m] = *(const LAS bf16x8*)(sl + 8192 + (16 * m + fr) * 64 + 16 * fq); }
        bf16x8 sb[2];
#pragma unroll
        for (int s = 0; s < 2; ++s) { const v4u wv = (v4u){pg8::cvt_pk_bf16(S[2 * s][0], S[2 * s][1]), pg8::cvt_pk_bf16(S[2 * s][2], S[2 * s][3]), pg8::cvt_pk_bf16(S[2 * s + 1][0], S[2 * s + 1][1]), pg8::cvt_pk_bf16(S[2 * s + 1][2], S[2 * s + 1][3])};
            sb[s] = __builtin_bit_cast(bf16x8, wv); }
        asm volatile("s_waitcnt lgkmcnt(0)" ::: "memory"); __builtin_amdgcn_sched_barrier(0);
        f32x4 o[2];
#pragma unroll
        for (int ib = 0; ib < 2; ++ib) { o[ib] = (f32x4){0.f, 0.f, 0.f, 0.f};
#pragma unroll
            for (int s = 0; s < 2; ++s) { const bf16x8 qf = (bf16x8){qa[ib][s][0], qa[ib][s][1], qa[ib][s][2], qa[ib][s][3], qb[ib][s][0], qb[ib][s][1], qb[ib][s][2], qb[ib][s][3]};
                o[ib] = __builtin_amdgcn_mfma_f32_16x16x32_bf16(qf, sb[s], o[ib], 0, 0, 0); } }
#pragma unroll
        for (int m = 0; m < 4; ++m) { S[m] = S[m] * dec[m]; S[m] = __builtin_amdgcn_mfma_f32_16x16x32_bf16(kh[m], vt, S[m], 0, 0, 0); }
#pragma unroll
        for (int ib = 0; ib < 2; ++ib) { o[ib] = __builtin_amdgcn_mfma_f32_16x16x32_bf16(am[ib], vt, o[ib], 0, 0, 0);
            float* op = GO + ((size_t)b * RPB + (size_t)c * GCH + 16 * ib + 4 * fq) * 1024 + h * 128 + 16 * w + fr;
#pragma unroll
            for (int r = 0; r < 4; ++r) op[(size_t)r * 1024] = o[ib][r]; }
    }
    asm volatile("s_waitcnt vmcnt(0)" ::: "memory"); __builtin_amdgcn_s_barrier();
}
__device__ __forceinline__ void ph_gla_post(Ctx& F, int layer, int nu) {
    if (F.bid < nu) return;
    const int gw = (F.bid - nu) * NWAVES + F.wave, NGW = (F.G - nu) * NWAVES; const int lane = F.lane;
    const float* g0 = WSP(float, WS_GO); const float* g1 = g0 + (size_t)MROWS * 1024; const bf16* P = WSP(bf16, WS_P);
    const float* go = inp(F, I_GNORM) + layer * 128;
    const float gg0 = go[2 * lane], gg1 = go[2 * lane + 1];
    for (int it = gw; it < MROWS * 8; it += NGW) {
        const int r = it >> 3, h = it & 7; if (layer == 1 && (r % RPB) < TC) continue;
        const size_t o = (size_t)r * 1024 + h * 128 + 2 * lane;
        const f32x2 a = *(const GAS f32x2*)(g0 + o), bq = *(const GAS f32x2*)(g1 + o);
        const float y0 = a.x + bq.x, y1 = a.y + bq.y;
        const float rstd = 1.0f / sqrtf(wave_sum(y0 * y0 + y1 * y1) * (1.0f / 128.0f) + EPS);
        const unsigned zw = *(const GAS unsigned*)(P + (size_t)r * NP + C_GZ + h * 128 + 2 * lane);
        *(GAS unsigned*)(WSP(bf16, WS_ACAT) + (size_t)r * DM + 1024 + h * 128 + 2 * lane) = pk2(y0 * rstd * gg0 * bflo(zw), y1 * rstd * gg1 * bfhi(zw));
    }
}
__device__ __forceinline__ void ph_attn_gate(Ctx& F, int layer) {
    const bf16* P = WSP(bf16, WS_P); bf16* AT = WSP(bf16, WS_AT);
    for (size_t e = (size_t)F.bid * NTHR + F.tid; e < (size_t)MROWS * 256; e += (size_t)F.G * NTHR) {
        const size_t r = e >> 8; const int c8 = (int)(e & 255) * 8; if (layer == 1 && (r % RPB) < TC) continue;
        const v4u a = *(const GAS v4u*)(AT + r * 2048 + c8), g = *(const GAS v4u*)(P + r * NP + C_AZ + c8);
        v4u o; o.x = pk2(bflo(a.x) * bflo(g.x), bfhi(a.x) * bfhi(g.x)); o.y = pk2(bflo(a.y) * bflo(g.y), bfhi(a.y) * bfhi(g.y));
        o.z = pk2(bflo(a.z) * bflo(g.z), bfhi(a.z) * bfhi(g.z)); o.w = pk2(bflo(a.w) * bflo(g.w), bfhi(a.w) * bfhi(g.w));
        *(GAS v4u*)(WSP(bf16, WS_ACAT) + r * DM + 2048 + c8) = o;
    }
}
__device__ __forceinline__ int s5_jrow(int dir, int so) { return dir == 0 ? so : (so < TC ? TC - 1 - so : RPB + TC - 1 - so); }
__device__ __forceinline__ int s5_uoff(int j) { return (j * 32) ^ (((j >> 4) & 7) << 5); }
constexpr int S5_XCH_OFF = RPB * 32;
__device__ __forceinline__ void s5_job(Ctx& F, int layer, int job) {
    const int b = job >> 6, g = job & 63; const int lane = F.lane, fr = lane & 15, fq = lane >> 4, w = F.wave;
    const bf16* P = WSP(bf16, WS_P);
    LAS unsigned char* UL = F.lds + RING_OFF; LAS f32x2* XCH = (LAS f32x2*)(F.lds + RING_OFF + S5_XCH_OFF);
    float* E = WSP(float, WS_E) + (size_t)job * SNCH * 128; bf16* HS = WSP(bf16, WS_HS) + (size_t)job * SNCH * 128;
    float* YF = WSP(float, WS_YF); bf16* GB = WSP(bf16, WS_GB);
    __syncthreads();
    { v4u uv[17];
#pragma unroll
      for (int q = 0; q < 17; ++q) { const int idx = F.tid + 512 * q; uv[q] = *(const GAS v4u*)(WSP(bf16, WS_UB) + ((size_t)b * 64 + g) * RPB * 16 + (size_t)idx * 8); }
#pragma unroll
      for (int q = 0; q < 17; ++q) { const int idx = F.tid + 512 * q; *(LAS v4u*)(UL + s5_uoff(idx >> 1) + (idx & 1) * 16) = uv[q]; } }
    __syncthreads();
#pragma unroll 1
    for (int dir = 0; dir < 2; ++dir) {
        const int item = (layer * 2 + dir) * 64 + g;
        const bf16* TG = WSP(bf16, WS_TG) + (size_t)item * 256 * 384; const bf16* WT = WSP(bf16, WS_WT) + (size_t)item * 128 * 256; const float* L16 = WSP(float, WS_L16) + (size_t)item * 128;
        {
            bf16x8 bw[8];
#pragma unroll
            for (int s = 0; s < 8; ++s) bw[s] = *(const GAS bf16x8*)(WT + (size_t)(16 * w + fr) * 256 + 32 * s + 8 * fq);
#pragma unroll 1
            for (int mb_ = 0; mb_ < 17; ++mb_) { int mb = mb_; asm volatile("" : "+s"(mb)); f32x4 acc = {0.f, 0.f, 0.f, 0.f}; const int k = 16 * mb + fr;
#pragma unroll
                for (int s = 0; s < 8; ++s) { const bf16x8 a = *(const LAS bf16x8*)(UL + s5_uoff(s5_jrow(dir, 16 * k + 2 * s + (fq >> 1))) + (fq & 1) * 16); acc = __builtin_amdgcn_mfma_f32_16x16x32_bf16(a, bw[s], acc, 0, 0, 0); }
#pragma unroll
                for (int r = 0; r < 4; ++r) E[(size_t)(16 * mb + 4 * fq + r) * 128 + 16 * w + fr] = acc[r]; }
        }
        VM_WAIT(); __syncthreads();
        { const float pr = L16[2 * lane], pi = L16[2 * lane + 1]; const int k0 = 34 * w;
            float er[34], ei[34];
            { const float* ep = E + (size_t)k0 * 128 + 2 * lane;
#pragma unroll
              for (int q = 0; q < 34; ++q) { const f32x2 t = *(const GAS f32x2*)ep; er[q] = t.x; ei[q] = t.y; ep += 128; asm volatile("" : "+v"(ep)); } }
            float lr = 0.f, li = 0.f;
#pragma unroll
            for (int q = 0; q < 34; ++q) { const float tx = er[q], ty = ei[q]; er[q] = lr; ei[q] = li; const float nr = pr * lr - pi * li + tx, ni = pr * li + pi * lr + ty; lr = nr; li = ni; }
            float qr = pr, qi = pi, p2r, p2i;
            { float tr = qr * qr - qi * qi, ti = 2.f * qr * qi; qr = tr; qi = ti; p2r = qr; p2i = qi; }
#pragma unroll
            for (int q = 0; q < 4; ++q) { const float tr = qr * qr - qi * qi, ti = 2.f * qr * qi; qr = tr; qi = ti; }
            const float p34r = qr * p2r - qi * p2i, p34i = qr * p2i + qi * p2r;
            XCH[w * 64 + lane] = (f32x2){lr, li};
            LDS_WAIT(); __syncthreads();
            float cr = 0.f, ci = 0.f;
            for (int v = 0; v < w; ++v) { const f32x2 x = XCH[v * 64 + lane]; const float nr = p34r * cr - p34i * ci + x.x, ni = p34r * ci + p34i * cr + x.y; cr = nr; ci = ni; }
            float wr_ = 1.f, wi_ = 0.f; bf16* hp = HS + (size_t)k0 * 128 + 2 * lane;
#pragma unroll
            for (int q = 0; q < 34; ++q) { const float hr = wr_ * cr - wi_ * ci + er[q], hi = wr_ * ci + wi_ * cr + ei[q];
                *(GAS unsigned*)hp = pk2(hr, hi); hp += 128; asm volatile("" : "+v"(hp));
                const float nr = wr_ * pr - wi_ * pi, ni = wr_ * pi + wi_ * pr; wr_ = nr; wi_ = ni; } }
        VM_WAIT(); __syncthreads();
        {
            bf16x8 bt[2][12];
#pragma unroll
            for (int nb = 0; nb < 2; ++nb)
#pragma unroll
                for (int s = 0; s < 12; ++s) bt[nb][s] = *(const GAS bf16x8*)(TG + (size_t)((2 * w + nb) * 16 + fr) * 384 + 32 * s + 8 * fq);
            const float dsk = inp(F, I_SSMD)[layer * 1024 + g * 16 + fr];
            bf16x8 hn[4], hn2[4]; float yn[2][4];
#pragma unroll
            for (int s = 0; s < 4; ++s) { hn[s] = *(const GAS bf16x8*)(HS + (size_t)fr * 128 + 32 * s + 8 * fq); hn2[s] = *(const GAS bf16x8*)(HS + (size_t)(16 + fr) * 128 + 32 * s + 8 * fq); }
#pragma unroll
            for (int nb = 0; nb < 2; ++nb)
#pragma unroll
                for (int r = 0; r < 4; ++r) { yn[nb][r] = 0.f; if (dir == 1) yn[nb][r] = YF[(((size_t)b * 64 + g) * RPB + s5_jrow(1, 16 * (4 * fq + r) + 2 * w + nb)) * 16 + fr]; }
#pragma unroll 1
            for (int mb_ = 0; mb_ < 17; ++mb_) { int mb = mb_; asm volatile("" : "+s"(mb)); f32x4 acc[2]; acc[0] = (f32x4){0.f, 0.f, 0.f, 0.f}; acc[1] = acc[0]; const int k = 16 * mb + fr;
                bf16x8 hc[4]; float yc[2][4];
#pragma unroll
                for (int s = 0; s < 4; ++s) { hc[s] = hn[s]; hn[s] = hn2[s]; }
#pragma unroll
                for (int nb = 0; nb < 2; ++nb)
#pragma unroll
                    for (int r = 0; r < 4; ++r) yc[nb][r] = yn[nb][r];
                { const int mn = mb + 2 < 17 ? mb + 2 : 16, m1 = mb + 1 < 17 ? mb + 1 : 16;
#pragma unroll
                  for (int s = 0; s < 4; ++s) hn2[s] = *(const GAS bf16x8*)(HS + (size_t)(16 * mn + fr) * 128 + 32 * s + 8 * fq);
                  if (dir == 1) {
#pragma unroll
                    for (int nb = 0; nb < 2; ++nb)
#pragma unroll
                        for (int r = 0; r < 4; ++r) yn[nb][r] = YF[(((size_t)b * 64 + g) * RPB + s5_jrow(1, 16 * (16 * m1 + 4 * fq + r) + 2 * w + nb)) * 16 + fr]; } }
#pragma unroll
                for (int s = 0; s < 12; ++s) { bf16x8 a;
                    if (s < 8) a = *(const LAS bf16x8*)(UL + s5_uoff(s5_jrow(dir, 16 * k + 2 * s + (fq >> 1))) + (fq & 1) * 16); else a = hc[s - 8];
                    acc[0] = __builtin_amdgcn_mfma_f32_16x16x32_bf16(a, bt[0][s], acc[0], 0, 0, 0); acc[1] = __builtin_amdgcn_mfma_f32_16x16x32_bf16(a, bt[1][s], acc[1], 0, 0, 0);
                    if (s == 3 || s == 7) asm volatile("" ::: "memory"); }
#pragma unroll
                for (int nb = 0; nb < 2; ++nb)
#pragma unroll
                    for (int r = 0; r < 4; ++r) { const int jr = s5_jrow(dir, 16 * (16 * mb + 4 * fq + r) + 2 * w + nb); const size_t o = ((size_t)b * RPB + jr) * 1024 + g * 16 + fr;
                        if (dir == 0) YF[(((size_t)b * 64 + g) * RPB + jr) * 16 + fr] = acc[nb][r];
                        else { const float u = bf2f(*(const LAS bf16*)(UL + s5_uoff(jr) + fr * 2)); GB[o] = (bf16)f2bf(gelu_tanh(acc[nb][r] + yc[nb][r] + dsk * u)); } } }
        }
        VM_WAIT(); __syncthreads();
    }
}
__device__ __forceinline__ void attn_unit(Ctx& F, int layer, int b, int h, size_t qrow, int seq) {
    att::attn_dense_body<att::bf16>((const att::bf16*)(WSP(bf16, WS_P) + qrow * NP + C_AQ + h * 128), (const att::bf16*)(WSP(bf16, WS_KN) + (size_t)b * RPB * 512 + (h >> 2) * 128),
        (const att::bf16*)(WSP(bf16, WS_VN) + (size_t)b * RPB * 512 + (h >> 2) * 128), WSP(bf16, WS_AT) + qrow * 2048 + h * 128, seq, (char*)(F.lds + RING_OFF), F.tid,
        NP, inp(F, I_AQG) + layer * 128, WSP(float, WS_ROPE), seq == TC ? -1 : (int)(qrow - (size_t)b * RPB) - TC);
    VM_WAIT(); __syncthreads();
    { const bf16* P = WSP(bf16, WS_P); const bf16* AT = WSP(bf16, WS_AT); bf16* AC = WSP(bf16, WS_ACAT);
#pragma unroll
      for (int q = 0; q < 8; ++q) { const int e = F.tid + 512 * q; const size_t r = qrow + (e >> 4); const int c8 = h * 128 + (e & 15) * 8;
        const v4u a = *(const GAS v4u*)(AT + r * 2048 + c8), g = *(const GAS v4u*)(P + r * NP + C_AZ + c8);
        v4u o; o.x = pk2(bflo(a.x) * bflo(g.x), bfhi(a.x) * bfhi(g.x)); o.y = pk2(bflo(a.y) * bflo(g.y), bfhi(a.y) * bfhi(g.y));
        o.z = pk2(bflo(a.z) * bflo(g.z), bfhi(a.z) * bfhi(g.z)); o.w = pk2(bflo(a.w) * bflo(g.w), bfhi(a.w) * bfhi(g.w));
        *(GAS v4u*)(AC + r * DM + 2048 + c8) = o; } }
}

__device__ __forceinline__ void ph_inproj_reduce(Ctx& F) {
    pg8::InProjOrder O; O.init(MROWS, NP, F.G, F.bid, 1, 1 << 30);
    const float* PT = WSP(float, WS_PARTP); bf16* P = WSP(bf16, WS_P); bf16* UB = WSP(bf16, WS_UB);
    for (int it = F.bid * NTHR + F.tid; it < 62 * 8192; it += F.G * NTHR) {
        const int e = it >> 13, rr = (it >> 5) & 255, c8 = (it & 31) * 8;
        pg8::Unit u; O.at(2816 + e, u);
        f32x4 v0 = {0.f, 0.f, 0.f, 0.f}, v1 = v0;
#pragma unroll
        for (int ks = 0; ks < 4; ++ks) { const float* pp = PT + ((size_t)(e * 4 + ks) * 256 + rr) * 256 + c8; v0 += *(const GAS f32x4*)pp; v1 += *(const GAS f32x4*)(pp + 4); }
        const int pn = u.pn; const int act = (pn >= 40 && pn < 88) ? 2 : (((pn >= 4 && pn < 8) || (pn >= 16 && pn < 20) || (pn >= 32 && pn < 40)) ? 1 : 0);
        if (act == 1) {
#pragma unroll
            for (int j = 0; j < 4; ++j) { v0[j] = siluf_(v0[j]); v1[j] = siluf_(v1[j]); } }
        else if (act == 2) {
#pragma unroll
            for (int j = 0; j < 4; ++j) { v0[j] = sigmoidf_(v0[j]); v1[j] = sigmoidf_(v1[j]); } }
        const v4u o = (v4u){pk2(v0[0], v0[1]), pk2(v0[2], v0[3]), pk2(v1[0], v1[1]), pk2(v1[2], v1[3])};
        const int row = u.pm * 256 + rr, col = pn * 256 + c8;
        if (pn < 4) { const int bb = u.pm / 17, jj = (u.pm % 17) * 256 + rr; *(GAS v4u*)(UB + (((size_t)bb * 64 + (col >> 4)) * RPB + jj) * 16 + (col & 15)) = o; }
        else *(GAS v4u*)(P + (size_t)row * NP + col) = o;
    }
}
#ifndef REP_PRO
#define REP_PRO 1
#endif
#ifndef REP_INPROJ
#define REP_INPROJ 1
#endif
#ifndef REP_PREP
#define REP_PREP 1
#endif
#ifndef REP_MIX
#define REP_MIX 1
#endif
#ifndef REP_S5
#define REP_S5 1
#endif
#ifndef REP_GSEQ
#define REP_GSEQ 1
#endif
#ifndef REP_ATT
#define REP_ATT 1
#endif
#ifndef REP_MERGE
#define REP_MERGE 1
#endif
#ifndef REP_NORM
#define REP_NORM 1
#endif
constexpr int ST_PRO = 0, ST_MODR = 1, ST_L0 = 2, ST_PER_L = 7, ST_FINAL = ST_L0 + 2 * ST_PER_L, NSTEPS = ST_FINAL + 1;
struct Args { const float* in[N_IN]; float* out; unsigned char* ws; int lo, hi, li, pad; };
__global__ void __launch_bounds__(NTHR, 2) fwd(Args args) {
    extern __shared__ __attribute__((aligned(16))) unsigned char lds[];
    Ctx F;
    F.lds = (LAS unsigned char*)lds;
    F.MISC = (volatile LAS unsigned*)(F.lds + MISC_OFF);
    F.tid = threadIdx.x; F.lane = F.tid & 63; F.wave = __builtin_amdgcn_readfirstlane(F.tid >> 6);
    F.G = gridDim.x; F.bid = blockIdx.x;
    F.ws = args.ws; F.out = args.out; F.ctl = (gu32*)(args.ws + WS_CTL);
    for (int u = F.tid; u < (LDS_BYTES - LDSCTL_OFF) / 4; u += NTHR) ((LAS unsigned*)(F.lds + LDSCTL_OFF))[u] = 0u;
    __syncthreads();
    if (F.tid < N_IN) *(LAS unsigned long long*)(F.lds + INTAB_OFF + 8 * F.tid) = (unsigned long long)args.in[F.tid];
    __syncthreads();
    XcdBarrier bar = xcd_barrier_post((unsigned*)(F.ctl + CW_BAR) + args.li * XCD_BAR_WORDS, F.MISC + 8);
    const int lo = args.lo, hi = args.hi; const int wave0 = F.wave;
#define IN(k) (lo <= (k) && (k) < hi)
#define REFRESH() do { int w_ = wave0; asm volatile("" : "+s"(w_)); int l_; asm volatile("v_mbcnt_lo_u32_b32 %0, -1, 0\n\tv_mbcnt_hi_u32_b32 %0, -1, %0" : "=v"(l_)); F.wave = w_; F.lane = l_; F.tid = w_ * 64 + l_; } while (0)
#define SEAM(k) do { if (IN(k) && IN((k) + 1)) xcd_barrier(bar); } while (0)

    if (IN(ST_PRO)) for (int rep_ = 0; rep_ < REP_PRO; ++rep_) { REFRESH();
#ifndef DIS_PRO
 ph_rope_table(F);
            { const int NL1 = (F.G == 256) ? 322 : 0, NMEM = 384 + TJ_JOBS + NL1, NJ = NMEM + 256;
              for (;;) {
                __syncthreads();
                if (F.tid == 0) F.MISC[16] = __hip_atomic_fetch_add((unsigned*)(F.ctl + CW_TQ + 64 * (5 + 8 * rep_)), 1u, RLX_AGENT);
                __syncthreads();
                const int j = (int)F.MISC[16];
                if (j >= NJ) break;
                REFRESH();
                const int stride = NJ / 256, s = j / stride;
                if (j % stride == 0 && s < 256) { s5_mats_item(F, s); continue; }
                const int m = j - (s + 1 < 256 ? s + 1 : 256);
                if (m < 384) mod_partial_item(F, m);
                else if (m < 384 + TJ_JOBS) transpose_job(F, 0, m - 384);
                else transpose_job(F, 1, m - 384 - TJ_JOBS);
              } }
#endif
 }
    SEAM(ST_PRO);
    if (IN(ST_MODR)) { REFRESH(); ph_mod_reduce(F); }
    SEAM(ST_MODR);
#pragma unroll 1
    for (int l = 0; l < 2; ++l) {
        const int sb = ST_L0 + ST_PER_L * l;
        if (IN(sb + 0)) for (int rep_ = 0; rep_ < REP_NORM; ++rep_) { REFRESH();
#ifndef DIS_NORM
 ph_norm(F, l, F.G == 256);
#endif
 }
        SEAM(sb + 0);
        if (IN(sb + 1)) for (int rep_ = 0; rep_ < REP_INPROJ; ++rep_) { REFRESH();
            pg8::Gemm g{WSP(bf16, WS_H), WSP(bf16, WS_WIN) + (size_t)l * NP * DM, MROWS, NP, DM, DM, DM}; const bool ksplit = (l == 1 && F.G == 256 && lo == 0 && hi == NSTEPS);
            pg8::InProjOrder S; S.init(MROWS, NP, F.G, F.bid, l, ksplit ? 11 : (1 << 30));
            pg8::EpiInProj E{WSP(bf16, WS_P), WSP(bf16, WS_UB)};
#ifndef DIS_G1
            pg8::gemm_phase<pg8::EpiInProj, pg8::InProjOrder, true, true>(F.lds + RING_OFF, g, S, E, F.tid);
#endif
            if (ksplit) { REFRESH();
                pg8::Gemm g2{WSP(bf16, WS_H), WSP(bf16, WS_WIN) + (size_t)l * NP * DM, MROWS, NP, 1024, DM, DM}; pg8::InProjSplitOrder S2; S2.init(MROWS, NP, F.G, F.bid);
                pg8::EpiPartial E2{WSP(float, WS_PARTP)};
                pg8::gemm_phase<pg8::EpiPartial, pg8::InProjSplitOrder, true, true>(F.lds + RING_OFF, g2, S2, E2, F.tid);
                xcd_barrier(bar); REFRESH(); ph_inproj_reduce(F); }
        }
        SEAM(sb + 1);
        if (IN(sb + 2)) for (int rep_ = 0; rep_ < REP_PREP; ++rep_) { REFRESH();
            for (;;) {
                __syncthreads();
                if (F.tid == 0) F.MISC[16] = __hip_atomic_fetch_add((unsigned*)(F.ctl + CW_PQ + 64 * (l + 2 * rep_)), 1u, RLX_AGENT);
                __syncthreads();
                const int j = (int)F.MISC[16];
                if (j >= NB * GNCH + MROWS / 32) break;
                REFRESH();
                if (j < NB * GNCH) gla_prep_item(F, l, j); else attn_prep_rows(F, l, (j - NB * GNCH) * 32, (j - NB * GNCH) * 32 + 32);
            }
 }
        SEAM(sb + 2);
        if (IN(sb + 3)) for (int rep_ = 0; rep_ < REP_MIX; ++rep_) { REFRESH();
            const int n_ctx = (l == 0) ? 32 : 0, n_jobs = 160 + n_ctx + 512;
            for (;;) {
                __syncthreads();
                if (F.tid == 0) F.MISC[16] = __hip_atomic_fetch_add((unsigned*)(F.ctl + CW_QUEUE + 64 * (l + 2 * rep_)), 1u, RLX_AGENT);
                __syncthreads();
                const int j = (int)F.MISC[16];
                if (j >= n_jobs) break;
                REFRESH();
                if (j < 32) {
#ifndef DIS_GSEQ
                    for (int rs_ = 0; rs_ < REP_GSEQ; ++rs_) gla_seq_job(F, l, j);
#endif
                } else if (j < 160) {
#ifndef DIS_S5
                    for (int rs_ = 0; rs_ < REP_S5; ++rs_) s5_job(F, l, j - 32);
#endif
                } else { const int u = j - 160; const bool isc = u >= 512; const int uu = isc ? u - 512 : u;
                    const int b = isc ? (uu >> 4) : (uu >> 8), h = isc ? (uu & 15) : ((uu >> 4) & 15), qb = uu & 15;
#ifndef DIS_ATT
                    for (int ra_ = 0; ra_ < REP_ATT; ++ra_) { if (ra_) { __syncthreads(); REFRESH(); } attn_unit(F, l, b, h, (size_t)b * RPB + (isc ? 0 : TC + qb * 256), isc ? TC : RPB); }
#endif
                }
            }
#if REP_MIX > 1
            if (rep_ + 1 < REP_MIX) xcd_barrier(bar);
#endif
        }
        SEAM(sb + 3);
        if (IN(sb + 4)) for (int rep_ = 0; rep_ < REP_MERGE; ++rep_) { REFRESH();
#ifndef DIS_GPOST
            ph_gla_post(F, l, (l == 1 && F.G == 256) ? 128 : 0);
#endif
            pg8::Gemm g{WSP(bf16, WS_GB), WSP(bf16, WS_WGLU) + (size_t)l * 1024 * 1024, MROWS, 1024, 1024, 1024, 1024}; pg8::RowOrder S; S.init(MROWS, 1024, F.G, F.bid, l);
            pg8::EpiGlu E{WSP(bf16, WS_GB), WSP(bf16, WS_P), WSP(bf16, WS_ACAT)};
#ifndef DIS_G2
            pg8::gemm_phase<pg8::EpiGlu, pg8::RowOrder, true, true>(F.lds + RING_OFF, g, S, E, F.tid);
#endif
            if (l == 0) { REFRESH(); transposes_fill(F, (unsigned*)(F.ctl + CW_TQ + 64 * (0 + 8 * rep_)), 322, 552); }
        }
        SEAM(sb + 4);
        if (IN(sb + 5)) for (int rep_ = 0; rep_ < REP_MERGE; ++rep_) { REFRESH();
            pg8::RowOrder S; S.init(MROWS, DM, F.G, F.bid, l);
            pg8::Gemm g{WSP(bf16, WS_ACAT), WSP(bf16, WS_WCAT) + (size_t)l * DM * DM, MROWS, DM, DM, DM, DM};
            pg8::EpiProjCat E{WSP(bf16, WS_P), WSP(bf16, WS_MRG)};
#ifndef DIS_G3
            pg8::gemm_phase<pg8::EpiProjCat, pg8::RowOrder, true, true>(F.lds + RING_OFF, g, S, E, F.tid);
#endif
            if (l == 0) { REFRESH(); transposes_fill(F, (unsigned*)(F.ctl + CW_TQ + 64 * (1 + 8 * rep_)), 552, 1952); }
        }
        SEAM(sb + 5);
        if (IN(sb + 6)) for (int rep_ = 0; rep_ < REP_MERGE; ++rep_) { REFRESH();
            const bool ctxsplit = (l == 0 && F.G == 256);
            pg8::Gemm g{WSP(bf16, WS_MRG), WSP(bf16, WS_WO) + (size_t)l * DM * DM, MROWS, DM, DM, DM, DM}; pg8::RowOrder S; S.init(MROWS, DM, F.G, F.bid, (l == 1 || ctxsplit) ? 1 : 0);
            pg8::EpiOut E{inp(F, I_X), inp(F, I_CTX), WSP(float, WS_X1), F.out, WSP(float, WS_MOD) + (size_t)l * 3 * 12288, l};
#ifndef DIS_G4
            pg8::gemm_phase<pg8::EpiOut, pg8::RowOrder, true, true>(F.lds + RING_OFF, g, S, E, F.tid);
#endif
            if (ctxsplit) { REFRESH();
                pg8::Gemm g2{WSP(bf16, WS_MRG), WSP(bf16, WS_WO), MROWS, DM, 512, DM, DM}; pg8::CtxSplitOrder S2; S2.init(F.G, F.bid);
                pg8::EpiOutCtxPartial E2{WSP(float, WS_PART)};
                pg8::gemm_phase<pg8::EpiOutCtxPartial, pg8::CtxSplitOrder, true, true>(F.lds + RING_OFF, g2, S2, E2, F.tid); }
            if (l == 0 && !ctxsplit) { REFRESH(); transposes_fill(F, (unsigned*)(F.ctl + CW_TQ + 64 * (4 + 8 * rep_)), 0, 322); }
        }
        SEAM(sb + 6);
    }
    if (IN(ST_FINAL)) { REFRESH();
#ifndef DIS_FINAL
 ph_final(F);
#endif
 }
#undef IN
#undef REFRESH
#undef SEAM
}

#ifndef MK_ONE_LAUNCH
#define MK_ONE_LAUNCH 1
#endif
extern "C" void kernel_launch(void* const* d_in, const int* in_sizes, int n_in, void* d_out, int out_size, void* d_ws, size_t ws_size, hipStream_t stream) {
    static int grid = 0;
    if (grid == 0) {
        if (n_in != N_IN || in_sizes[0] != NB * TL * DM || out_size != NB * TL * DM || ws_size < WS_END) {
            fprintf(stderr, "kernel_launch: shape mismatch: n_in %d in0 %d out %d ws %zu (need %zu); nothing launched\n", n_in, n_in > 0 ? in_sizes[0] : -1, out_size, ws_size, (size_t)WS_END); grid = -1; return; }
        int dev = 0, cus = 0, per_cu = 0;
        if (hipGetDevice(&dev) != hipSuccess || hipDeviceGetAttribute(&cus, hipDeviceAttributeMultiprocessorCount, dev) != hipSuccess) { fprintf(stderr, "kernel_launch: device query failed\n"); grid = -1; return; }
        if (hipFuncSetAttribute((const void*)fwd, hipFuncAttributeMaxDynamicSharedMemorySize, LDS_BYTES) != hipSuccess) { fprintf(stderr, "kernel_launch: hipFuncSetAttribute failed\n"); grid = -1; return; }
        if (hipOccupancyMaxActiveBlocksPerMultiprocessor(&per_cu, (const void*)fwd, NTHR, LDS_BYTES) != hipSuccess || per_cu < 1)
            fprintf(stderr, "kernel_launch: note: occupancy query reports %d workgroups per CU\n", per_cu);
        (void)hipGetLastError();
        grid = cus;
    }
    if (grid < 0) return;
    if (hipMemsetAsync((char*)d_ws + WS_CTL, 0, CTL_ZERO_BYTES, stream) != hipSuccess) { fprintf(stderr, "kernel_launch: memset failed\n"); return; }
    Args a{};
    for (int i = 0; i < N_IN; ++i) a.in[i] = (const float*)d_in[i];
    a.out = (float*)d_out; a.ws = (unsigned char*)d_ws; a.pad = 0;
#if MK_ONE_LAUNCH
    a.lo = 0; a.hi = NSTEPS; a.li = 0;
    hipLaunchKernelGGL(fwd, dim3(grid), dim3(NTHR), LDS_BYTES, stream, a);
#else
    for (int s = 0; s < NSTEPS; ++s) { a.lo = s; a.hi = s + 1; a.li = s; hipLaunchKernelGGL(fwd, dim3(grid), dim3(NTHR), LDS_BYTES, stream, a); }
#endif
    const hipError_t le = hipPeekAtLastError();
    if (le != hipSuccess) fprintf(stderr, "kernel_launch: launch failed: %s\n", hipGetErrorName(le));
}
```
